# Optimizing an MI355X kernel written in HIP

```python
import math
import jax, jax.numpy as jnp
from jax import lax
import numpy as np

D_MODEL = 1024
BATCH = 2
SEQ = 16384
DEPTH = 2
DEC_BATCH = 8
DEC_SEQ = 16
PAST_LEN = 2048

CHUNK = 64
N_MIXERS = 2
N_LAYERS_A = (DEPTH + 1) // 2
N_LAYERS_B = DEPTH // 2
A_HEADS = 16
A_HEAD_DIM = D_MODEL // A_HEADS
BAND_CHUNKS = 8
BAND_PAST = BAND_CHUNKS * CHUNK
REL_CLIP = 128
B_HEADS = 4
B_KEY_DIM = D_MODEL // 2 // B_HEADS
B_VAL_DIM = D_MODEL // B_HEADS
B_QK = B_HEADS * B_KEY_DIM
B_VD = B_HEADS * B_VAL_DIM
B_GATE_RANK = 16
B_GATE_NORM = 16.0
D_FF = -(-8 * D_MODEL // 768) * 256
ALPHA = (2.0 * DEPTH) ** 0.25
BETA = (8.0 * DEPTH) ** -0.25
LN_EPS = 1e-5
GN_EPS = 1e-6
NEG_INF = -1e30

kernel_name = "hybrid_stream_chunkattn_gla_step"


def _layer_norm(x, g, b):
    xf = x.astype(jnp.float32)
    mu = jnp.mean(xf, axis=-1, keepdims=True)
    var = jnp.mean(jnp.square(xf - mu), axis=-1, keepdims=True)
    return ((xf - mu) * lax.rsqrt(var + LN_EPS)).astype(x.dtype) * g + b


def _swiglu(x, w_in, w_out):
    gate, up = jnp.split(x @ w_in, 2, axis=-1)
    return (jax.nn.silu(gate) * up) @ w_out


def _rel_bias(rel_table, q_pos, k_pos):
    d = jnp.clip(q_pos[:, None] - k_pos[None, :], -REL_CLIP, REL_CLIP) + REL_CLIP
    return jnp.transpose(rel_table[d], (2, 0, 1)).astype(jnp.float32)


def _attend(q, k, v, bias, mask):
    s = jnp.einsum('bqhd,bkhd->bhqk', q.astype(jnp.float32), k.astype(jnp.float32))
    s = s * (A_HEAD_DIM ** -0.5) + bias[None]
    if mask is not None:
        s = jnp.where(mask[None, None], s, NEG_INF)
    p = jax.nn.softmax(s, axis=-1).astype(v.dtype)
    return jnp.einsum('bhqk,bkhd->bqhd', p, v)


def _split_heads(t, h, d):
    return t.reshape(t.shape[0], t.shape[1], h, d)


def mixer_a_prompt(x, w_in, rel_table, w_out):
    bsz, t_len, _ = x.shape
    q, k, v = jnp.split(x @ w_in, 3, axis=-1)
    q, k, v = (_split_heads(a, A_HEADS, A_HEAD_DIM) for a in (q, k, v))
    n_chunks = t_len // CHUNK
    band = BAND_PAST + CHUNK
    pad = ((0, 0), (BAND_PAST, 0), (0, 0), (0, 0))
    kp = jnp.pad(k, pad)
    vp = jnp.pad(v, pad)
    offs_q = jnp.arange(CHUNK)
    offs_k = jnp.arange(band) - BAND_PAST
    bias = _rel_bias(rel_table, offs_q, offs_k)

    def one_chunk(c):
        start = c * CHUNK
        qc = lax.dynamic_slice_in_dim(q, start, CHUNK, axis=1)
        kc = lax.dynamic_slice_in_dim(kp, start, band, axis=1)
        vc = lax.dynamic_slice_in_dim(vp, start, band, axis=1)
        valid = (start + offs_k) >= 0
        mask = jnp.broadcast_to(valid[None, :], (CHUNK, band))
        return _attend(qc, kc, vc, bias, mask)

    out = lax.map(one_chunk, jnp.arange(n_chunks))
    out = jnp.transpose(out, (1, 0, 2, 3, 4)).reshape(bsz, t_len, D_MODEL)
    keep = min(BAND_PAST, t_len)
    return out @ w_out, k[:, t_len - keep:], v[:, t_len - keep:]


def mixer_a_sample(x, cache_k, cache_v, w_in, rel_table, w_out):
    bsz, t_len, _ = x.shape
    n_cache = cache_k.shape[1]
    q, k, v = jnp.split(x @ w_in, 3, axis=-1)
    q, k, v = (_split_heads(a, A_HEADS, A_HEAD_DIM) for a in (q, k, v))
    kk = jnp.concatenate([cache_k.astype(k.dtype), k], axis=1)
    vv = jnp.concatenate([cache_v.astype(v.dtype), v], axis=1)
    bias = _rel_bias(rel_table, n_cache + jnp.arange(t_len), jnp.arange(n_cache + t_len))
    out = _attend(q, kk, vv, bias, None).reshape(bsz, t_len, D_MODEL)
    return out @ w_out, k, v


def _gla_project(x, w_in, w_gk_up, b_gk):
    q, k, v, r, gk_low = jnp.split(x @ w_in, [B_QK, 2 * B_QK, 2 * B_QK + B_VD, 2 * B_QK + 2 * B_VD], axis=-1)
    q = _split_heads(q, B_HEADS, B_KEY_DIM).astype(jnp.float32) * (B_KEY_DIM ** -0.5)
    k = _split_heads(k, B_HEADS, B_KEY_DIM).astype(jnp.float32)
    v = _split_heads(v, B_HEADS, B_VAL_DIM).astype(jnp.float32)
    g = jax.nn.log_sigmoid((gk_low @ w_gk_up + b_gk).astype(jnp.float32)) / B_GATE_NORM
    g = _split_heads(g, B_HEADS, B_KEY_DIM)
    return q, k, v, g, r


def _gla_chunk(s_prev, q, k, v, g):
    b = jnp.cumsum(g, axis=1)
    c_len = q.shape[1]
    causal = jnp.tril(jnp.ones((c_len, c_len), bool))
    expo = jnp.where(causal[None, :, :, None, None], b[:, :, None] - b[:, None, :], -jnp.inf)
    attn = jnp.einsum('bihd,bjhd,bijhd->bhij', q, k, jnp.exp(expo))
    o = jnp.einsum('bhij,bjhv->bihv', attn, v) + jnp.einsum('bihd,bhdv->bihv', q * jnp.exp(b), s_prev)
    b_last = b[:, -1]
    k_dec = k * jnp.exp(b_last[:, None] - b)
    s_new = s_prev * jnp.exp(b_last)[..., None] + jnp.einsum('bjhd,bjhv->bhdv', k_dec, v)
    return s_new, o


def _gla_output(o, r, gn_gain, w_out):
    o = o * lax.rsqrt(jnp.mean(jnp.square(o), axis=-1, keepdims=True) + GN_EPS)
    o = o.reshape(o.shape[0], o.shape[1], B_VD).astype(r.dtype) * gn_gain
    return (o * jax.nn.silu(r)) @ w_out


def mixer_b_prompt(x, w_in, w_gk_up, b_gk, gn_gain, w_out):
    bsz, t_len, _ = x.shape
    q, k, v, g, r = _gla_project(x, w_in, w_gk_up, b_gk)
    n_chunks = t_len // CHUNK

    def to_chunks(a):
        return jnp.transpose(a.reshape(bsz, n_chunks, CHUNK, a.shape[2], a.shape[3]), (1, 0, 2, 3, 4))

    def step(s, inp):
        qc, kc, vc, gc = inp
        return _gla_chunk(s, qc, kc, vc, gc)

    s0 = jnp.zeros((bsz, B_HEADS, B_KEY_DIM, B_VAL_DIM), jnp.float32)
    s_fin, o = lax.scan(step, s0, (to_chunks(q), to_chunks(k), to_chunks(v), to_chunks(g)))
    o = jnp.transpose(o, (1, 0, 2, 3, 4)).reshape(bsz, t_len, B_HEADS, B_VAL_DIM)
    return _gla_output(o, r, gn_gain, w_out), s_fin


def mixer_b_sample(x, state, w_in, w_gk_up, b_gk, gn_gain, w_out):
    q, k, v, g, r = _gla_project(x, w_in, w_gk_up, b_gk)
    s_new, o = _gla_chunk(state.astype(jnp.float32), q, k, v, g)
    return _gla_output(o, r, gn_gain, w_out), s_new


def setup_inputs(seed: int = 0) -> dict:
    key = jax.random.key(seed)
    ks = jax.random.split(key, 24)

    def nrm(k, shape, s):
        return jax.random.normal(k, shape, jnp.float32) * s

    a_cache_len = min(BAND_PAST, PAST_LEN)
    s_in = D_MODEL ** -0.5
    w_in_a = jnp.concatenate([nrm(ks[5], (N_LAYERS_A, D_MODEL, 2 * D_MODEL), s_in),
                              nrm(ks[6], (N_LAYERS_A, D_MODEL, D_MODEL), s_in * BETA)], axis=-1)
    w_in_b = jnp.concatenate([nrm(ks[9], (N_LAYERS_B, D_MODEL, 2 * B_QK), s_in),
                              nrm(ks[10], (N_LAYERS_B, D_MODEL, B_VD), s_in * BETA),
                              nrm(ks[11], (N_LAYERS_B, D_MODEL, B_VD), s_in),
                              nrm(ks[12], (N_LAYERS_B, D_MODEL, B_GATE_RANK), s_in)], axis=-1)
    return {
        "x_prompt": nrm(ks[0], (BATCH, SEQ, D_MODEL), 1.0),
        "x_sample": nrm(ks[1], (DEC_BATCH, DEC_SEQ, D_MODEL), 1.0),
        "cache_a_k": nrm(ks[2], (N_LAYERS_A, DEC_BATCH, a_cache_len, A_HEADS, A_HEAD_DIM), 1.0),
        "cache_a_v": nrm(ks[3], (N_LAYERS_A, DEC_BATCH, a_cache_len, A_HEADS, A_HEAD_DIM), BETA),
        "state_b": nrm(ks[4], (N_LAYERS_B, DEC_BATCH, B_HEADS, B_KEY_DIM, B_VAL_DIM), 0.5),
        "w_in_a": w_in_a,
        "rel_bias_a": nrm(ks[7], (N_LAYERS_A, 2 * REL_CLIP + 1, A_HEADS), 0.5),
        "w_out_a": nrm(ks[8], (N_LAYERS_A, D_MODEL, D_MODEL), s_in * BETA),
        "w_in_b": w_in_b,
        "w_gk_up_b": nrm(ks[13], (N_LAYERS_B, B_GATE_RANK, B_QK), B_GATE_RANK ** -0.5),
        "b_gk_b": nrm(ks[14], (N_LAYERS_B, B_QK), 0.1),
        "gn_gain_b": 1.0 + nrm(ks[15], (N_LAYERS_B, B_VD), 0.02),
        "w_out_b": nrm(ks[16], (N_LAYERS_B, B_VD, D_MODEL), (B_VD ** -0.5) * BETA),
        "w_ffn_in": nrm(ks[17], (DEPTH, D_MODEL, 2 * D_FF), s_in * BETA),
        "w_ffn_out": nrm(ks[18], (DEPTH, D_FF, D_MODEL), (D_FF ** -0.5) * BETA),
        "ln1_g": 1.0 + nrm(ks[19], (DEPTH, D_MODEL), 0.02),
        "ln1_b": nrm(ks[20], (DEPTH, D_MODEL), 0.02),
        "ln2_g": 1.0 + nrm(ks[21], (DEPTH, D_MODEL), 0.02),
        "ln2_b": nrm(ks[22], (DEPTH, D_MODEL), 0.02),
    }


def reference(x_prompt, x_sample, cache_a_k, cache_a_v, state_b,
              w_in_a, rel_bias_a, w_out_a,
              w_in_b, w_gk_up_b, b_gk_b, gn_gain_b, w_out_b,
              w_ffn_in, w_ffn_out, ln1_g, ln1_b, ln2_g, ln2_b):
    xp, xs = x_prompt, x_sample
    ak_p, av_p, sb_p, ak_s, av_s, sb_s = [], [], [], [], [], []
    for i in range(DEPTH):
        j = i // N_MIXERS
        if i % N_MIXERS == 0:
            mp, kp_new, vp_new = mixer_a_prompt(xp, w_in_a[j], rel_bias_a[j], w_out_a[j])
            ms, ks_new, vs_new = mixer_a_sample(xs, cache_a_k[j], cache_a_v[j], w_in_a[j], rel_bias_a[j], w_out_a[j])
            ak_p.append(kp_new); av_p.append(vp_new)
            ak_s.append(ks_new); av_s.append(vs_new)
        else:
            mp, sp_new = mixer_b_prompt(xp, w_in_b[j], w_gk_up_b[j], b_gk_b[j], gn_gain_b[j], w_out_b[j])
            ms, ss_new = mixer_b_sample(xs, state_b[j], w_in_b[j], w_gk_up_b[j], b_gk_b[j], gn_gain_b[j], w_out_b[j])
            sb_p.append(sp_new); sb_s.append(ss_new)
        xp = _layer_norm(ALPHA * xp + mp, ln1_g[i], ln1_b[i])
        xs = _layer_norm(ALPHA * xs + ms, ln1_g[i], ln1_b[i])
        xp = _layer_norm(ALPHA * xp + _swiglu(xp, w_ffn_in[i], w_ffn_out[i]), ln2_g[i], ln2_b[i])
        xs = _layer_norm(ALPHA * xs + _swiglu(xs, w_ffn_in[i], w_ffn_out[i]), ln2_g[i], ln2_b[i])
    return (xp, xs, jnp.stack(ak_p), jnp.stack(av_p), jnp.stack(sb_p),
            jnp.stack(ak_s), jnp.stack(av_s), jnp.stack(sb_s))
```

```cpp
#include <hip/hip_runtime.h>
#include <hip/hip_cooperative_groups.h>
#include <cstdint>
#include <cstdio>
namespace cg = cooperative_groups;
#ifndef MK_MULTI
#define MK_MULTI 0
#endif
namespace pg8 {
#define PG8_LAS __attribute__((address_space(3)))
typedef unsigned short bf16_t;
typedef short bf16x8 __attribute__((ext_vector_type(8)));
typedef float f32x4 __attribute__((ext_vector_type(4)));
typedef unsigned u32x4 __attribute__((ext_vector_type(4)));
constexpr int BM = 256, BK = 64, HALF = 128, HTB = HALF * BK * 2  , STAGE_BYTES = 8 * HTB, NXCD = 8, WGM = 8;

__host__ __device__ __forceinline__ int lds_byte(int r, int c) { const int st = (r >> 4) * 2 + (c >> 5), rr = r & 15, cc = c & 31, ob = rr * 64 + cc * 2; return st * 1024 + (ob ^ (((ob >> 9) & 1) << 5)); }
__host__ __device__ __forceinline__ void stage_rc(int b, int& R, int& C) { const int st = b / 1024, sb = b % 1024, swz = sb ^ (((sb >> 9) & 1) << 5); R = (st >> 1) * 16 + swz / 64; C = (st & 1) * 32 + (swz % 64) / 2; }
__host__ __device__ __forceinline__ int perm32(int rho) { const int n = rho >> 4, i = rho & 15; return 8 * (i >> 2) + 4 * n + (i & 3); }

struct Unit { int pm, pn; };
struct Gemm { const bf16_t* A; const bf16_t* Bt; int M, N, K; };

struct StaticOrder {
    int nM, nN, nwg, G, c;
    __host__ __device__ void init(int M, int N, int G_, int c_) { nM = M / BM; nN = N / BM; nwg = nM * nN; G = G_; c = c_; }
    __host__ __device__ bool next(int i, Unit& u) const {
        const long L = (long)i * G + c; if (L >= nwg) return false;
        int wgid = (int)L; { const int q = nwg / NXCD, r = nwg % NXCD, xcd = wgid % NXCD, off = wgid / NXCD; wgid = (xcd < r ? xcd * (q + 1) : r * (q + 1) + (xcd - r) * q) + off; }
        const int nig = WGM * nN, gid = wgid / nig, fm = gid * WGM, gsz = (nM - fm) < WGM ? (nM - fm) : WGM;
        u.pm = fm + ((wgid % nig) % gsz); u.pn = (wgid % nig) / gsz; return true;
    }
    __device__ __forceinline__ void a_ready(const Unit&) const {}
    __device__ __forceinline__ void done(const Unit&) const {}
};

__device__ __forceinline__ unsigned cvt_pk_bf16(float lo, float hi) { unsigned r; asm volatile("v_cvt_pk_bf16_f32 %0, %1, %2" : "=v"(r) : "v"(lo), "v"(hi)); return r; }
typedef float f32x2 __attribute__((ext_vector_type(2)));
template <class Epi, class Sched, bool ALIGN_EPI = false, bool SP2 = false, bool ATILED = false>
__device__ __forceinline__ void gemm_phase(PG8_LAS unsigned char* lds, const Gemm g, const Sched& S, const Epi& E) {
    int tid_ = threadIdx.x; asm volatile("" : "+v"(tid_));
    const int tid = tid_, wid = __builtin_amdgcn_readfirstlane(tid >> 6), lane = tid & 63, wr = wid >> 2, wc = wid & 3, fr = lane & 15, fq = lane >> 4;
    const int K = g.K, nt = K / BK;
    unsigned voffA[2], voffB[2];
#pragma unroll
    for (int i = 0; i < 2; ++i) { int R, C; stage_rc(tid * 16 + i * 8192, R, C); const int Rb = Epi::PERM ? ((R & ~31) + perm32(R & 31)) : R;
        voffA[i] = ATILED ? (unsigned)(R * 64 + C) * 2u : (unsigned)(R * K + C) * 2u; voffB[i] = (unsigned)(Rb * K + C) * 2u; }
    const size_t kstep = (size_t)(BK * 2);
    const size_t hstep = (size_t)HALF * K * 2;
    const size_t tstep = 2 * hstep;
    const size_t kstepA = ATILED ? (size_t)32768 : kstep, hstepA = ATILED ? (size_t)16384 : hstep, tstepA = ATILED ? (size_t)(K / 64) * 32768 : tstep;
    const unsigned ldsw = (unsigned)wid * 1024u;
    const int aoff = lds_byte(wr * 64 + fr, fq * 8), boff = lds_byte(wc * 32 + fr, fq * 8);
#define PG8_SA(b, h) (((b) * 2 + (h)) * HTB)
#define PG8_SB(b, h) ((4 + (b) * 2 + (h)) * HTB)
#define PG8_STAGE(bufoff, gbase, voff) do { _Pragma("unroll") for (int _i = 0; _i < 2; ++_i) \
        __builtin_amdgcn_global_load_lds((const unsigned*)((const char*)(gbase) + (voff)[_i]), (PG8_LAS unsigned*)(lds + (bufoff) + ldsw + _i * 8192), 16, 0, 0); } while (0)
#define PG8_LDA(dst, b, h) do { _Pragma("unroll") for (int m = 0; m < 4; ++m) _Pragma("unroll") for (int k = 0; k < 2; ++k) dst[m][k] = *(const PG8_LAS bf16x8*)(lds + PG8_SA(b, h) + aoff + m * 2048 + k * 1024); } while (0)
#define PG8_LDB(dst, b, h) do { _Pragma("unroll") for (int n = 0; n < 2; ++n) _Pragma("unroll") for (int k = 0; k < 2; ++k) dst[n][k] = *(const PG8_LAS bf16x8*)(lds + PG8_SB(b, h) + boff + n * 2048 + k * 1024); } while (0)
#define PG8_MMA(ai, bj, At, Bt) do { __builtin_amdgcn_s_setprio(1); _Pragma("unroll") for (int m = 0; m < 4; ++m) _Pragma("unroll") for (int n = 0; n < 2; ++n) _Pragma("unroll") for (int k = 0; k < 2; ++k) \
        acc[ai][bj][m][n] = __builtin_amdgcn_mfma_f32_16x16x32_bf16(Bt[n][k], At[m][k], acc[ai][bj][m][n], 0, 0, 0); __builtin_amdgcn_s_setprio(0); } while (0)
#define PG8_WAIT_V(n) asm volatile("s_waitcnt vmcnt(" #n ")" ::: "memory")
#define PG8_WAIT_L(n) asm volatile("s_waitcnt lgkmcnt(" #n ")" ::: "memory")
#define PG8_BAR __builtin_amdgcn_s_barrier()
#define PG8_SCHED __builtin_amdgcn_sched_barrier(0)
    Unit cur, nxt; int ui = 0;
    if (!S.next(0, cur)) return;
    f32x4 acc[2][2][4][2];
#pragma unroll
    for (int a = 0; a < 2; ++a)
#pragma unroll
        for (int b = 0; b < 2; ++b)
#pragma unroll
            for (int m = 0; m < 4; ++m)
#pragma unroll
                for (int n = 0; n < 2; ++n) acc[a][b][m][n] = (f32x4){0.f, 0.f, 0.f, 0.f};
    bf16x8 At[4][2], B0[2][2], B1[2][2];
    const char* cA = (const char*)g.A + (size_t)cur.pm * tstepA; const char* cB = (const char*)g.Bt + (size_t)cur.pn * tstep;
    S.a_ready(cur);
    if constexpr (SP2) {
        PG8_STAGE(PG8_SB(0, 0), cB, voffB); PG8_STAGE(PG8_SB(0, 1), cB + hstep, voffB); PG8_STAGE(PG8_SA(0, 0), cA, voffA); PG8_STAGE(PG8_SA(0, 1), cA + hstepA, voffA);
        if (wr == 1) PG8_BAR;
        PG8_WAIT_V(2); PG8_BAR;
        PG8_STAGE(PG8_SB(1, 0), cB + kstep, voffB); PG8_STAGE(PG8_SA(1, 0), cA + kstepA, voffA); PG8_STAGE(PG8_SB(1, 1), cB + hstep + kstep, voffB);
        PG8_WAIT_V(6); PG8_BAR;
    } else {
        PG8_STAGE(PG8_SB(0, 0), cB, voffB); PG8_STAGE(PG8_SA(0, 0), cA, voffA); PG8_STAGE(PG8_SB(0, 1), cB + hstep, voffB); PG8_STAGE(PG8_SA(0, 1), cA + hstepA, voffA);
        if (wr == 1) PG8_BAR;
        PG8_WAIT_V(4); PG8_BAR;
        PG8_STAGE(PG8_SB(1, 0), cB + kstep, voffB); PG8_STAGE(PG8_SA(1, 0), cA + kstepA, voffA); PG8_STAGE(PG8_SB(1, 1), cB + hstep + kstep, voffB);
        PG8_WAIT_V(6); PG8_BAR;
    }
    for (;;) {
        const bool has_next = S.next(ui + 1, nxt);
        const char* nA = has_next ? (const char*)g.A + (size_t)nxt.pm * tstepA : cA; const char* nB = has_next ? (const char*)g.Bt + (size_t)nxt.pn * tstep : cB;
        for (int t = 0; t < nt; t += 2) {
            const bool last = (t == nt - 2);
            const char* a1 = cA + (size_t)(t + 1) * kstepA;
            const char* a2 = last ? nA : cA + (size_t)(t + 2) * kstepA; const char* b2 = last ? nB : cB + (size_t)(t + 2) * kstep;
            const char* a3 = a2 + kstepA; const char* b3 = b2 + kstep;
            if (last && has_next) S.a_ready(nxt);
            if constexpr (SP2) {
            PG8_LDB(B0, 0, 0); PG8_LDB(B1, 0, 1); PG8_SCHED; PG8_LDA(At, 0, 0); PG8_STAGE(PG8_SA(1, 1), a1 + hstepA, voffA);
            PG8_WAIT_V(8); PG8_WAIT_L(0); PG8_BAR; PG8_MMA(0, 0, At, B0); PG8_MMA(0, 1, At, B1); PG8_BAR; PG8_SCHED;
            PG8_LDA(At, 0, 1); PG8_STAGE(PG8_SB(0, 0), b2, voffB); PG8_STAGE(PG8_SB(0, 1), b2 + hstep, voffB); PG8_STAGE(PG8_SA(0, 0), a2, voffA);
            PG8_WAIT_V(8); PG8_WAIT_L(0); PG8_BAR; PG8_MMA(1, 0, At, B0); PG8_MMA(1, 1, At, B1); PG8_BAR; PG8_SCHED;
            PG8_LDB(B0, 1, 0); PG8_LDB(B1, 1, 1); PG8_SCHED; PG8_LDA(At, 1, 0); PG8_STAGE(PG8_SA(0, 1), a2 + hstepA, voffA);
            PG8_WAIT_V(8); PG8_WAIT_L(0); PG8_BAR; PG8_MMA(0, 0, At, B0); PG8_MMA(0, 1, At, B1); PG8_BAR; PG8_SCHED;
            PG8_LDA(At, 1, 1); PG8_STAGE(PG8_SB(1, 0), b3, voffB); PG8_STAGE(PG8_SB(1, 1), b3 + hstep, voffB); PG8_STAGE(PG8_SA(1, 0), a3, voffA);
            PG8_WAIT_V(8); PG8_WAIT_L(0); PG8_BAR; PG8_MMA(1, 0, At, B0); PG8_MMA(1, 1, At, B1); PG8_BAR; PG8_SCHED;
            } else {
            PG8_LDB(B0, 0, 0); PG8_SCHED; PG8_LDA(At, 0, 0); PG8_STAGE(PG8_SA(1, 1), a1 + hstepA, voffA);
            PG8_WAIT_L(8); PG8_BAR; PG8_WAIT_L(0); PG8_MMA(0, 0, At, B0); PG8_BAR; PG8_SCHED;
            PG8_LDB(B1, 0, 1); PG8_STAGE(PG8_SB(0, 0), b2, voffB);
            PG8_BAR; PG8_WAIT_L(0); PG8_MMA(0, 1, At, B1); PG8_BAR;
            PG8_LDA(At, 0, 1); PG8_STAGE(PG8_SA(0, 0), a2, voffA);
            PG8_BAR; PG8_WAIT_L(0); PG8_MMA(1, 0, At, B0); PG8_BAR; PG8_SCHED;
            PG8_STAGE(PG8_SB(0, 1), b2 + hstep, voffB);
            PG8_WAIT_V(6); PG8_BAR; PG8_MMA(1, 1, At, B1); PG8_BAR;
            PG8_LDB(B0, 1, 0); PG8_SCHED; PG8_LDA(At, 1, 0); PG8_STAGE(PG8_SA(0, 1), a2 + hstepA, voffA);
            PG8_WAIT_L(8); PG8_BAR; PG8_WAIT_L(0); PG8_MMA(0, 0, At, B0); PG8_BAR; PG8_SCHED;
            PG8_LDB(B1, 1, 1); PG8_STAGE(PG8_SB(1, 0), b3, voffB);
            PG8_BAR; PG8_WAIT_L(0); PG8_MMA(0, 1, At, B1); PG8_BAR;
            PG8_LDA(At, 1, 1); PG8_STAGE(PG8_SA(1, 0), a3, voffA);
            PG8_BAR; PG8_WAIT_L(0); PG8_MMA(1, 0, At, B0); PG8_BAR; PG8_SCHED;
            PG8_STAGE(PG8_SB(1, 1), b3 + hstep, voffB);
            PG8_WAIT_V(6); PG8_BAR; PG8_MMA(1, 1, At, B1); PG8_BAR;
            }
        }
        if constexpr (ALIGN_EPI) { if (wr == 0) PG8_BAR; }
        if constexpr (!Epi::AFTER_DRAIN) { E(acc, cur, wr, wc, fr, fq); S.done(cur); }
        if (!has_next) break;
#pragma unroll
        for (int a = 0; a < 2; ++a)
#pragma unroll
            for (int b = 0; b < 2; ++b)
#pragma unroll
                for (int m = 0; m < 4; ++m)
#pragma unroll
                    for (int n = 0; n < 2; ++n) acc[a][b][m][n] = (f32x4){0.f, 0.f, 0.f, 0.f};
        cur = nxt; cA = nA; cB = nB; ++ui;
        if constexpr (ALIGN_EPI) { if (wr == 1) PG8_BAR; }
    }
    PG8_WAIT_V(0);
    if constexpr (!ALIGN_EPI) { if (wr == 0) PG8_BAR; }
    PG8_BAR;
    if constexpr (Epi::AFTER_DRAIN) { E.fused(acc, cur, wr, wc, fr, fq, lds, wid, lane); S.done(cur); }
#undef PG8_SA
#undef PG8_SB
#undef PG8_STAGE
#undef PG8_LDA
#undef PG8_LDB
#undef PG8_MMA
#undef PG8_WAIT_V
#undef PG8_WAIT_L
#undef PG8_BAR
#undef PG8_SCHED
}
}
using pg8::bf16_t; using pg8::bf16x8; using pg8::f32x4;
typedef float f32x16 __attribute__((ext_vector_type(16)));
typedef unsigned u32x2 __attribute__((ext_vector_type(2)));
typedef unsigned u32x4 __attribute__((ext_vector_type(4)));
#define LAS __attribute__((address_space(3)))

constexpr int DM = 1024, SEQ = 16384, MP = 32768, MS = 128, DFF = 2816, NGLA = 3328;
constexpr float ALPHA = 1.4142135623730951f;
constexpr float LOG2E = 1.4426950408889634f;
constexpr float QSCALE = 0.125f * LOG2E;
constexpr float LN_EPS = 1e-5f, GN_EPS = 1e-6f;
constexpr int LDS_BYTES = 131072 + 256;

constexpr size_t MiB = 1u << 20;
constexpr size_t WS_WINA = 2 * MiB, WS_WOUTA = 8 * MiB, WS_WINB = 10 * MiB, WS_WOUTB = 17 * MiB, WS_WFI = 19 * MiB, WS_WFO = 41 * MiB;
constexpr size_t WS_X = 64 * MiB, ACT = 128 * MiB;
constexpr size_t WS_Q = ACT, WS_KB = ACT + 64 * MiB, WS_VT = ACT + 128 * MiB, WS_AO = ACT + 192 * MiB, WS_H = ACT;
constexpr size_t WS_QG = ACT, WS_KG = ACT + 32 * MiB, WS_VT1 = ACT + 64 * MiB, WS_RG = ACT + 128 * MiB, WS_GL = ACT + 192 * MiB, WS_KET = ACT + 194 * MiB,
                 WS_OG = ACT + 226 * MiB, WS_TG = ACT + 290 * MiB, WS_DEC = ACT + 322 * MiB, WS_PDG = ACT + 323 * MiB;
constexpr size_t SMP = 452 * MiB;
constexpr size_t WS_XS = SMP, WS_QS = SMP + 256 * 1024, WS_KSA = SMP + 1 * MiB, WS_VTSA = SMP + 10 * MiB, WS_HS = SMP + 19 * MiB, WS_QGS = SMP + 20 * MiB,
                 WS_KGS = SMP + 20 * MiB + 512 * 1024, WS_VTS = SMP + 21 * MiB, WS_RGS = SMP + 22 * MiB, WS_GLS = SMP + 22 * MiB + 256 * 1024,
                 WS_KETS = SMP + 22 * MiB + 512 * 1024, WS_DECS = SMP + 23 * MiB, WS_OGS = SMP + 23 * MiB + 256 * 1024, WS_AOS = SMP + 23 * MiB + 512 * 1024;
constexpr size_t O_YP = 0, O_YS = 33554432, O_AKP = 33685504, O_AVP = 34734080, O_SBP = 35782656, O_AKS = 36044800, O_AVS = 36175872, O_SBS = 36306944;

__device__ __forceinline__ unsigned pk2(float lo, float hi) { typedef float f2 __attribute__((ext_vector_type(2))); typedef __bf16 b2 __attribute__((ext_vector_type(2))); f2 v = {lo, hi}; b2 b = __builtin_convertvector(v, b2); return __builtin_bit_cast(unsigned, b); }
__device__ __forceinline__ bf16_t f2bf(float f) { return (bf16_t)(pk2(f, 0.f) & 0xffffu); }
__device__ __forceinline__ float bflo(unsigned u) { return __uint_as_float(u << 16); }
__device__ __forceinline__ float bfhi(unsigned u) { return __uint_as_float(u & 0xffff0000u); }
__device__ __forceinline__ float bf2f(bf16_t b) { return __uint_as_float((unsigned)b << 16); }
__device__ __forceinline__ float silu_f(float x) { return x * __builtin_amdgcn_rcpf(1.f + __builtin_amdgcn_exp2f(-x * LOG2E)); }
__device__ __forceinline__ float xhalf_max(float v) { auto rr = __builtin_amdgcn_permlane32_swap(__float_as_uint(v), __float_as_uint(v), false, false); return fmaxf(__uint_as_float(rr[0]), __uint_as_float(rr[1])); }
__device__ __forceinline__ float xhalf_sum(float v) { auto rr = __builtin_amdgcn_permlane32_swap(__float_as_uint(v), __float_as_uint(v), false, false); return __uint_as_float(rr[0]) + __uint_as_float(rr[1]); }
__device__ __forceinline__ float wave_sum(float v) {
#pragma unroll
    for (int o = 1; o < 64; o <<= 1) v += __shfl_xor(v, o);
    return v;
}
__device__ __forceinline__ bf16x8 pack8(const f32x16& p, int s8) {
    u32x4 w; w.x = pk2(p[s8 + 0], p[s8 + 1]); w.y = pk2(p[s8 + 2], p[s8 + 3]); w.z = pk2(p[s8 + 4], p[s8 + 5]); w.w = pk2(p[s8 + 6], p[s8 + 7]);
    return __builtin_bit_cast(bf16x8, w);
}
__device__ __forceinline__ int swap23(int v) { return (v & 0x13) | ((v & 4) << 1) | ((v & 8) >> 1); }
__device__ __forceinline__ size_t kf_addr(int bh, int nkt, int key, int d) { return ((((size_t)bh * nkt + (key >> 5)) * 4 + (d >> 4)) * 64 + ((d >> 3) & 1) * 32 + swap23(key & 31)) * 8 + (d & 7); }
__device__ __forceinline__ size_t vf_addr(int bh, int nkt, int key, int d) { return (((((size_t)bh * nkt + (key >> 5)) * 2 + (d >> 5)) * 2 + ((key >> 4) & 1)) * 64 + ((key >> 3) & 1) * 32 + (d & 31)) * 8 + (key & 7); }
#define MFMA32(a, b, c) __builtin_amdgcn_mfma_f32_32x32x16_bf16((a), (b), (c), 0, 0, 0)

struct EpiQKV {
    static constexpr bool PERM = true, AFTER_DRAIN = false;
    bf16_t *Q, *KB, *VT; float *akp, *avp;
    __device__ __forceinline__ void operator()(const f32x4 (&acc)[2][2][4][2], const pg8::Unit& u, int wr, int wc, int fr, int fq) const {
        const int sec = u.pn >> 2; const int cbase = (u.pn & 3) * 256 + wc * 32 + fq * 8;
        const int rbase = u.pm * 256 + wr * 64 + fr;
        if (sec == 0) {
            bf16_t* dst = Q + (size_t)rbase * 1024 + cbase;
#pragma unroll
            for (int ai = 0; ai < 2; ++ai)
#pragma unroll
                for (int m = 0; m < 4; ++m) {
#pragma unroll
                    for (int bj = 0; bj < 2; ++bj) { const f32x4 v0 = acc[ai][bj][m][0], v1 = acc[ai][bj][m][1];
                        u32x4 w; w.x = pk2(v0[0] * QSCALE, v0[1] * QSCALE); w.y = pk2(v0[2] * QSCALE, v0[3] * QSCALE); w.z = pk2(v1[0] * QSCALE, v1[1] * QSCALE); w.w = pk2(v1[2] * QSCALE, v1[3] * QSCALE);
                        *(u32x4*)(dst + (ai * 128 + m * 16) * 1024 + bj * 128) = w; }
                    asm volatile("" ::: "memory");
                }
        } else if (sec == 1) {
            const int b = rbase >> 14, tl0 = rbase & 16383;
#pragma unroll
            for (int bj = 0; bj < 2; ++bj) { const int c = cbase + bj * 128;
#pragma unroll
                for (int ai = 0; ai < 2; ++ai)
#pragma unroll
                    for (int m = 0; m < 4; ++m) { const f32x4 v0 = acc[ai][bj][m][0], v1 = acc[ai][bj][m][1];
                        u32x4 w; w.x = pk2(v0[0], v0[1]); w.y = pk2(v0[2], v0[3]); w.z = pk2(v1[0], v1[1]); w.w = pk2(v1[2], v1[3]);
                        *(u32x4*)(KB + kf_addr(b * 16 + (c >> 6), 512, tl0 + ai * 128 + m * 16, c & 63)) = w; }
                asm volatile("" ::: "memory"); }
        } else {
            const int b = rbase >> 14, tl0 = rbase & 16383;
#pragma unroll
            for (int bj = 0; bj < 2; ++bj) { const int c = cbase + bj * 128;
#pragma unroll
                for (int ai = 0; ai < 2; ++ai)
#pragma unroll
                    for (int m = 0; m < 4; ++m) { bf16_t* d2 = VT + vf_addr(b * 16 + (c >> 6), 512, tl0 + ai * 128 + m * 16, c & 63);
#pragma unroll
                        for (int n = 0; n < 2; ++n)
#pragma unroll
                            for (int e = 0; e < 4; ++e) d2[(4 * n + e) * 8] = f2bf(acc[ai][bj][m][n][e]); }
                asm volatile("" ::: "memory"); }
        }
        if (sec >= 1 && (rbase & 16383) >= 15872) {
            float* dst = (sec == 1 ? akp : avp) + (size_t)((rbase >> 14) * 512 + (rbase & 16383) - 15872) * 1024 + cbase;
#pragma unroll
            for (int ai = 0; ai < 2; ++ai)
#pragma unroll
                for (int m = 0; m < 4; ++m) {
#pragma unroll
                    for (int bj = 0; bj < 2; ++bj)
#pragma unroll
                        for (int n = 0; n < 2; ++n) *(f32x4*)(dst + (ai * 128 + m * 16) * 1024 + bj * 128 + n * 4) = acc[ai][bj][m][n];
                    asm volatile("" ::: "memory");
                }
        }
    }
};
template <int MODE>
struct EpiVT {
    static constexpr bool PERM = true, AFTER_DRAIN = false;
    bf16_t* VT; float* avp;
    __device__ __forceinline__ void operator()(const f32x4 (&acc)[2][2][4][2], const pg8::Unit& u, int wr, int wc, int fr, int fq) const {
        const int fbase = u.pm * 256 + wr * 64 + fr;
        const int tbase = u.pn * 256 + wc * 32 + fq * 8;
#pragma unroll
        for (int ai = 0; ai < 2; ++ai)
#pragma unroll
            for (int m = 0; m < 4; ++m) {
                const int f = fbase + ai * 128 + m * 16;
#pragma unroll
                for (int bj = 0; bj < 2; ++bj) {
                    const int tok = tbase + bj * 128; const int b = tok >> 14, tl = tok & 16383; const f32x4 v0 = acc[ai][bj][m][0], v1 = acc[ai][bj][m][1];
                    u32x4 w; w.x = pk2(v0[0], v0[1]); w.y = pk2(v0[2], v0[3]); w.z = pk2(v1[0], v1[1]); w.w = pk2(v1[2], v1[3]);
                    if (MODE == 0) {
                        *(u32x4*)(VT + vf_addr(b * 16 + (f >> 6), 512, tl, f & 63)) = w;
                        if (tl >= 15872) { float* d = avp + (size_t)(b * 512 + tl - 15872) * 1024 + f;
                            d[0] = v0[0]; d[1024] = v0[1]; d[2048] = v0[2]; d[3072] = v0[3]; d[4096] = v1[0]; d[5120] = v1[1]; d[6144] = v1[2]; d[7168] = v1[3]; }
                    } else {
                        *(u32x4*)(VT + (size_t)(b * 1024 + f) * 16384 + tl) = w;
                    }
                }
                asm volatile("" ::: "memory");
            }
    }
};
struct EpiGlaR {
    static constexpr bool PERM = true, AFTER_DRAIN = false;
    bf16_t* RG; float* GL;
    __device__ __forceinline__ void operator()(const f32x4 (&acc)[2][2][4][2], const pg8::Unit& u, int wr, int wc, int fr, int fq) const {
        const int pn = u.pn; const int cb = wc * 32 + fq * 8; const int rbase = u.pm * 256 + wr * 64 + fr;
        if (pn < 4) {
            bf16_t* dst = RG + (size_t)rbase * 1024 + pn * 256 + cb;
#pragma unroll
            for (int ai = 0; ai < 2; ++ai)
#pragma unroll
                for (int m = 0; m < 4; ++m) {
#pragma unroll
                    for (int bj = 0; bj < 2; ++bj) { const f32x4 v0 = acc[ai][bj][m][0], v1 = acc[ai][bj][m][1];
                        u32x4 w; w.x = pk2(v0[0], v0[1]); w.y = pk2(v0[2], v0[3]); w.z = pk2(v1[0], v1[1]); w.w = pk2(v1[2], v1[3]);
                        *(u32x4*)(dst + (size_t)(ai * 128 + m * 16) * 1024 + bj * 128) = w; }
                    asm volatile("" ::: "memory");
                }
        } else if (cb < 16) {
#pragma unroll
            for (int ai = 0; ai < 2; ++ai)
#pragma unroll
                for (int m = 0; m < 4; ++m) { float* gp = GL + (size_t)(rbase + ai * 128 + m * 16) * 16 + cb; *(f32x4*)gp = acc[ai][0][m][0]; *(f32x4*)(gp + 4) = acc[ai][0][m][1]; }
        }
    }
};
template <bool XT>
struct EpiResT {
    static constexpr bool PERM = true, AFTER_DRAIN = false;
    const bf16_t* X; bf16_t* PRE;
    __device__ __forceinline__ void operator()(const f32x4 (&acc)[2][2][4][2], const pg8::Unit& u, int wr, int wc, int fr, int fq) const {
        const size_t base = (size_t)(u.pm * 256 + wr * 64 + fr) * 1024 + u.pn * 256 + wc * 32 + fq * 8;
        const int r0_ = u.pm * 256 + wr * 64 + fr, c0_ = u.pn * 256 + wc * 32 + fq * 8;
        const bf16_t* xp = XT ? X + (((size_t)u.pm * 16 + (c0_ >> 6)) * 256 + (r0_ & 255)) * 64 + (c0_ & 63) : X + base; bf16_t* pp = PRE + base;
#pragma unroll
        for (int ai = 0; ai < 2; ++ai)
#pragma unroll
            for (int m = 0; m < 4; ++m) {
                u32x4 xx[2];
#pragma unroll
                for (int bj = 0; bj < 2; ++bj) xx[bj] = XT ? *(const u32x4*)(xp + (ai * 128 + m * 16) * 64 + bj * 2 * 16384) : *(const u32x4*)(xp + (ai * 128 + m * 16) * 1024 + bj * 128);
#pragma unroll
                for (int bj = 0; bj < 2; ++bj) {
                    const f32x4 v0 = acc[ai][bj][m][0], v1 = acc[ai][bj][m][1]; const u32x4 x4 = xx[bj];
                    u32x4 w; w.x = pk2(ALPHA * bflo(x4.x) + v0[0], ALPHA * bfhi(x4.x) + v0[1]); w.y = pk2(ALPHA * bflo(x4.y) + v0[2], ALPHA * bfhi(x4.y) + v0[3]);
                    w.z = pk2(ALPHA * bflo(x4.z) + v1[0], ALPHA * bfhi(x4.z) + v1[1]); w.w = pk2(ALPHA * bflo(x4.w) + v1[2], ALPHA * bfhi(x4.w) + v1[3]);
                    *(u32x4*)(pp + (ai * 128 + m * 16) * 1024 + bj * 128) = w;
                }
                asm volatile("" ::: "memory");
            }
    }
};
typedef EpiResT<false> EpiRes;
struct EpiSwi {
    static constexpr bool PERM = true, AFTER_DRAIN = false;
    bf16_t* H;
    __device__ __forceinline__ void operator()(const f32x4 (&acc)[2][2][4][2], const pg8::Unit& u, int wr, int wc, int fr, int fq) const {
        const int hc = u.pn * 128 + wc * 32 + fq * 8;
#pragma unroll
        for (int ai = 0; ai < 2; ++ai)
#pragma unroll
            for (int m = 0; m < 4; ++m) {
                const int row = u.pm * 256 + ai * 128 + wr * 64 + m * 16 + fr;
                const f32x4 g0 = acc[ai][0][m][0], g1 = acc[ai][0][m][1], u0 = acc[ai][1][m][0], u1 = acc[ai][1][m][1];
                u32x4 w; w.x = pk2(silu_f(g0[0]) * u0[0], silu_f(g0[1]) * u0[1]); w.y = pk2(silu_f(g0[2]) * u0[2], silu_f(g0[3]) * u0[3]);
                w.z = pk2(silu_f(g1[0]) * u1[0], silu_f(g1[1]) * u1[1]); w.w = pk2(silu_f(g1[2]) * u1[2], silu_f(g1[3]) * u1[3]);
                *(u32x4*)(H + ((((size_t)(row >> 8) * (DFF / 64) + (hc >> 6)) * 256 + (row & 255)) * 64 + (hc & 63))) = w;
            }
    }
};
struct EpiGla {
    static constexpr bool PERM = true, AFTER_DRAIN = false;
    bf16_t *QG, *KG, *VT, *RG; float* GL;
    __device__ __forceinline__ void operator()(const f32x4 (&acc)[2][2][4][2], const pg8::Unit& u, int wr, int wc, int fr, int fq) const {
        const int pn = u.pn; const int cb = wc * 32 + fq * 8; const int rbase = u.pm * 256 + wr * 64 + fr;
        if (pn < 4 || (pn >= 8 && pn < 12)) {
            bf16_t* dst; int ld;
            if (pn < 2) { dst = QG + (size_t)rbase * 512 + pn * 256 + cb; ld = 512; }
            else if (pn < 4) { dst = KG + (size_t)rbase * 512 + (pn - 2) * 256 + cb; ld = 512; }
            else { dst = RG + (size_t)rbase * 1024 + (pn - 8) * 256 + cb; ld = 1024; }
#pragma unroll
            for (int ai = 0; ai < 2; ++ai)
#pragma unroll
                for (int m = 0; m < 4; ++m) {
#pragma unroll
                    for (int bj = 0; bj < 2; ++bj) { const f32x4 v0 = acc[ai][bj][m][0], v1 = acc[ai][bj][m][1];
                        u32x4 w; w.x = pk2(v0[0], v0[1]); w.y = pk2(v0[2], v0[3]); w.z = pk2(v1[0], v1[1]); w.w = pk2(v1[2], v1[3]);
                        *(u32x4*)(dst + (size_t)(ai * 128 + m * 16) * ld + bj * 128) = w; }
                    asm volatile("" ::: "memory");
                }
        } else if (pn < 8) {
            const int b = rbase >> 14, tl0 = rbase & 16383;
            bf16_t* dst = VT + (size_t)(b * 1024 + (pn - 4) * 256 + cb) * 16384 + tl0;
#pragma unroll
            for (int bj = 0; bj < 2; ++bj)
#pragma unroll
                for (int n = 0; n < 2; ++n) {
#pragma unroll
                    for (int e = 0; e < 4; ++e) { bf16_t* d2 = dst + (size_t)(bj * 128 + n * 4 + e) * 16384;
#pragma unroll
                        for (int ai = 0; ai < 2; ++ai)
#pragma unroll
                            for (int m = 0; m < 4; ++m) d2[ai * 128 + m * 16] = f2bf(acc[ai][bj][m][n][e]);
                        asm volatile("" ::: "memory"); }
                }
        } else {
            if (cb < 16) {
#pragma unroll
                for (int ai = 0; ai < 2; ++ai)
#pragma unroll
                    for (int m = 0; m < 4; ++m) { float* gp = GL + (size_t)(rbase + ai * 128 + m * 16) * 16 + cb; *(f32x4*)gp = acc[ai][0][m][0]; *(f32x4*)(gp + 4) = acc[ai][0][m][1]; }
            }
        }
    }
};

template <bool DUAL, class F>
__device__ __forceinline__ void small_gemm(const bf16_t* A, const bf16_t* Bt, int K, int nct, LAS float* red, int wave, int lane_, const F& epi) {
    int lane = lane_; asm volatile("" : "+v"(lane));
    const int x = lane & 31, kq = lane >> 5; const int kw = K >> 3;
    constexpr int NC = DUAL ? 32 : 16;
    for (int it = blockIdx.x; it < 4 * nct; it += gridDim.x) {
        const int rt = it & 3, ct = it >> 2;
        int nb0, nb1; if (DUAL) { nb0 = (ct >> 2) * 256 + (ct & 3) * 32; nb1 = nb0 + 128; } else { nb0 = ct * 32; nb1 = nb0; }
        const bf16_t* pa = A + (size_t)(rt * 32 + x) * K + wave * kw + kq * 8;
        const bf16_t* pb0 = Bt + (size_t)(nb0 + x) * K + wave * kw + kq * 8;
        const bf16_t* pb1 = Bt + (size_t)(nb1 + x) * K + wave * kw + kq * 8;
        f32x16 c0 = f32x16{}, c1 = f32x16{};
#pragma unroll 8
        for (int k = 0; k < kw; k += 16) {
            const bf16x8 a = *(const bf16x8*)(pa + k), b0 = *(const bf16x8*)(pb0 + k);
            c0 = MFMA32(a, b0, c0);
            if (DUAL) { const bf16x8 b1 = *(const bf16x8*)(pb1 + k); c1 = MFMA32(a, b1, c1); }
        }
        LAS float* mine = red + (wave * 64 + lane) * (NC + 1);
#pragma unroll
        for (int r = 0; r < 16; ++r) { mine[r] = c0[r]; if (DUAL) mine[16 + r] = c1[r]; }
        __syncthreads();
#pragma unroll
        for (int rr = 0; rr < 2; ++rr) {
            const int r = 2 * wave + rr; float s0 = 0.f, s1 = 0.f;
#pragma unroll
            for (int ww = 0; ww < 8; ++ww) { const LAS float* p = red + (ww * 64 + lane) * (NC + 1); s0 += p[r]; if (DUAL) s1 += p[16 + r]; }
            const int row = rt * 32 + (r & 3) + 8 * (r >> 2) + 4 * kq;
            epi(row, ct * 32 + x, s0, s1);
        }
        __syncthreads();
    }
}
struct SQkv { bf16_t *QS, *KSA, *VTSA; float *aks, *avs;
    __device__ __forceinline__ void operator()(int row, int col, float v, float) const {
        const int bs = row >> 4, t = row & 15;
        if (col < 1024) QS[row * 1024 + col] = f2bf(v * QSCALE);
        else if (col < 2048) { const int c = col - 1024; KSA[kf_addr(bs * 16 + (c >> 6), 18, 512 + t, c & 63)] = f2bf(v); aks[row * 1024 + c] = v; }
        else { const int c = col - 2048; VTSA[vf_addr(bs * 16 + (c >> 6), 18, 512 + t, c & 63)] = f2bf(v); avs[row * 1024 + c] = v; }
    } };
struct SRes { const bf16_t* XS; float* PRE;
    __device__ __forceinline__ void operator()(int row, int col, float v, float) const { PRE[row * 1024 + col] = ALPHA * bf2f(XS[row * 1024 + col]) + v; } };
struct SSwi { bf16_t* HS;
    __device__ __forceinline__ void operator()(int row, int col, float g, float u) const { HS[row * DFF + col] = f2bf(silu_f(g) * u); } };
struct SGla { bf16_t *QGS, *KGS, *VTS, *RGS; float* GLS;
    __device__ __forceinline__ void operator()(int row, int col, float v, float) const {
        const int bs = row >> 4, t = row & 15, prow = bs * 64 + t;
        if (col < 512) QGS[prow * 512 + col] = f2bf(v);
        else if (col < 1024) KGS[prow * 512 + col - 512] = f2bf(v);
        else if (col < 2048) VTS[(size_t)(bs * 1024 + col - 1024) * 64 + t] = f2bf(v);
        else if (col < 3072) RGS[row * 1024 + col - 2048] = f2bf(v);
        else if (col < 3088) GLS[prow * 16 + col - 3072] = v;
    } };

template <int R>
__device__ __forceinline__ void ln_rows_t(const float* pre, int row, const float* g, const float* bta, bf16_t* xo, float* fo, int lane) {
    f32x4 v[R][4];
#pragma unroll
    for (int r = 0; r < R; ++r) { const f32x4* pr = (const f32x4*)(pre + (size_t)(row + r) * 1024) + lane;
#pragma unroll
        for (int j = 0; j < 4; ++j) v[r][j] = pr[64 * j]; }
    f32x4 gg[4], bb[4];
#pragma unroll
    for (int j = 0; j < 4; ++j) { gg[j] = ((const f32x4*)g)[lane + 64 * j]; bb[j] = ((const f32x4*)bta)[lane + 64 * j]; }
#pragma unroll
    for (int r = 0; r < R; ++r) {
        float s = 0.f;
#pragma unroll
        for (int j = 0; j < 4; ++j) s += (v[r][j][0] + v[r][j][1]) + (v[r][j][2] + v[r][j][3]);
        const float mean = wave_sum(s) * (1.f / 1024.f); float s2 = 0.f;
#pragma unroll
        for (int j = 0; j < 4; ++j) { v[r][j] = v[r][j] - mean; s2 += (v[r][j][0] * v[r][j][0] + v[r][j][1] * v[r][j][1]) + (v[r][j][2] * v[r][j][2] + v[r][j][3] * v[r][j][3]); }
        const float rstd = 1.f / sqrtf(wave_sum(s2) * (1.f / 1024.f) + LN_EPS);
#pragma unroll
        for (int j = 0; j < 4; ++j) {
            const f32x4 y = v[r][j] * rstd * gg[j] + bb[j];
            if (xo) { u32x2 w; w.x = pk2(y[0], y[1]); w.y = pk2(y[2], y[3]); *((u32x2*)(xo + (size_t)(row + r) * 1024) + lane + 64 * j) = w; }
            if (fo) *((f32x4*)(fo + (size_t)(row + r) * 1024) + lane + 64 * j) = y;
        }
    }
}
__device__ __forceinline__ void ln_rows(const float* pre, int nrows, const float* g, const float* bta, bf16_t* xo, float* fo, int gw, int ngw, int lane_) {
    int lane = lane_; asm volatile("" : "+v"(lane));
    for (int row = gw; row < nrows; row += ngw) ln_rows_t<1>(pre, row, g, bta, xo, fo, lane);
}
template <int R, bool XT = false>
__device__ __forceinline__ void lnb_rows(const bf16_t* pre, int nrows, const float* g, const float* bta, bf16_t* xo, float* fo, int gw, int ngw, int lane_) {
    int lane = lane_; asm volatile("" : "+v"(lane));
    f32x4 gg[4], bb[4];
#pragma unroll
    for (int j = 0; j < 2; ++j) { gg[2 * j] = *(const f32x4*)(g + 512 * j + 8 * lane); gg[2 * j + 1] = *(const f32x4*)(g + 512 * j + 8 * lane + 4);
                                  bb[2 * j] = *(const f32x4*)(bta + 512 * j + 8 * lane); bb[2 * j + 1] = *(const f32x4*)(bta + 512 * j + 8 * lane + 4); }
    for (int row = R * gw; row < nrows; row += R * ngw) {
        u32x4 raw[R][2];
#pragma unroll
        for (int r = 0; r < R; ++r)
#pragma unroll
            for (int j = 0; j < 2; ++j) raw[r][j] = *(const u32x4*)(pre + (size_t)(row + r) * 1024 + 512 * j + 8 * lane);
#pragma unroll
        for (int r = 0; r < R; ++r) {
            f32x4 v[4];
#pragma unroll
            for (int j = 0; j < 2; ++j) { const u32x4 w = raw[r][j]; v[2 * j] = f32x4{bflo(w.x), bfhi(w.x), bflo(w.y), bfhi(w.y)}; v[2 * j + 1] = f32x4{bflo(w.z), bfhi(w.z), bflo(w.w), bfhi(w.w)}; }
            float s = 0.f;
#pragma unroll
            for (int j = 0; j < 4; ++j) s += (v[j][0] + v[j][1]) + (v[j][2] + v[j][3]);
            const float mean = wave_sum(s) * (1.f / 1024.f); float s2 = 0.f;
#pragma unroll
            for (int j = 0; j < 4; ++j) { v[j] = v[j] - mean; s2 += (v[j][0] * v[j][0] + v[j][1] * v[j][1]) + (v[j][2] * v[j][2] + v[j][3] * v[j][3]); }
            const float rstd = 1.f / sqrtf(wave_sum(s2) * (1.f / 1024.f) + LN_EPS);
#pragma unroll
            for (int j = 0; j < 2; ++j) {
                const f32x4 y0 = v[2 * j] * rstd * gg[2 * j] + bb[2 * j], y1 = v[2 * j + 1] * rstd * gg[2 * j + 1] + bb[2 * j + 1];
                if (xo) { u32x4 w; w.x = pk2(y0[0], y0[1]); w.y = pk2(y0[2], y0[3]); w.z = pk2(y1[0], y1[1]); w.w = pk2(y1[2], y1[3]); if (XT) { const int rr_ = row + r, cc_ = 512 * j + 8 * lane; *(u32x4*)(xo + ((((size_t)(rr_ >> 8) * 16 + (cc_ >> 6)) * 256 + (rr_ & 255)) * 64 + (cc_ & 63))) = w; }
                    else *(u32x4*)(xo + (size_t)(row + r) * 1024 + 512 * j + 8 * lane) = w; }
                if (fo) { *(f32x4*)(fo + (size_t)(row + r) * 1024 + 512 * j + 8 * lane) = y0; *(f32x4*)(fo + (size_t)(row + r) * 1024 + 512 * j + 8 * lane + 4) = y1; }
            }
        }
    }
}

#define LDS_WAIT() asm volatile("s_waitcnt lgkmcnt(0)" ::: "memory")
__device__ __forceinline__ void tr_item(const float* W, int K, int N, bf16_t* WT, int mode, LAS float* scr, int item, int lane_) {
    int lane = lane_; asm volatile("" : "+v"(lane));
    const int nblk = (N + 31) >> 5, kb = item / nblk, nb = item - kb * nblk, k0 = 64 * kb, n0 = 32 * nb;
    const int nn = n0 + (lane & 31); const bool ok = nn < N;
    float tv[32];
#pragma unroll
    for (int i = 0; i < 32; ++i) { const int kk = 2 * i + (lane >> 5); tv[i] = ok ? W[(size_t)(k0 + kk) * N + nn] : 0.f; }
#pragma unroll
    for (int i = 0; i < 32; ++i) { const int kk = 2 * i + (lane >> 5); scr[kk * 33 + (lane & 31)] = tv[i]; }
    LDS_WAIT();
    int r0 = n0;
    if (mode == 1) r0 = (n0 < DFF) ? ((n0 >> 7) * 256 + (n0 & 127)) : (((n0 - DFF) >> 7) * 256 + 128 + ((n0 - DFF) & 127));
    const int c = lane & 7;
#pragma unroll
    for (int j = 0; j < 4; ++j) { const int n = (lane >> 3) + 8 * j; const LAS float* s = scr + (8 * c) * 33 + n;
        u32x4 o; o.x = pk2(s[0 * 33], s[1 * 33]); o.y = pk2(s[2 * 33], s[3 * 33]); o.z = pk2(s[4 * 33], s[5 * 33]); o.w = pk2(s[6 * 33], s[7 * 33]);
        *(u32x4*)(WT + (size_t)(r0 + n) * K + k0 + 8 * c) = o; }
    LDS_WAIT();
}

template <int NQT>
__device__ __forceinline__ void attn_unit_safe(const bf16_t* Qp, int qvalid, const bf16_t* Kp, const bf16_t* Vtp, int kt_lo, int kt_hi, int nkeys,
                                          const LAS float* bias, float bconst, bf16_t* Op, int lane_) {
    int lane = lane_; asm volatile("" : "+v"(lane));
    const int x = lane & 31, hi = lane >> 5; const int sx = (x & 0x13) | ((x & 4) << 1) | ((x & 8) >> 1);
    bf16x8 qf[NQT][4];
#pragma unroll
    for (int qt = 0; qt < NQT; ++qt) { int qr = qt * 32 + x; if (qr >= qvalid) qr = qvalid - 1;
#pragma unroll
        for (int d0 = 0; d0 < 4; ++d0) qf[qt][d0] = *(const bf16x8*)(Qp + (size_t)qr * 1024 + d0 * 16 + hi * 8); }
    float mrow[NQT], lrow[NQT]; f32x16 o[NQT][2];
#pragma unroll
    for (int qt = 0; qt < NQT; ++qt) { mrow[qt] = -1e30f; lrow[qt] = 0.f; o[qt][0] = f32x16{}; o[qt][1] = f32x16{}; }
    bf16x8 kf[4], vf[2][2];
#define ATT_LOAD(KF, VF, kk) do { const bf16_t* kp_ = Kp + (long)(kk) * 2048 + lane * 8; const bf16_t* vp_ = Vtp + (long)(kk) * 2048 + lane * 8; \
        _Pragma("unroll") for (int d0 = 0; d0 < 4; ++d0) KF[d0] = *(const bf16x8*)(kp_ + d0 * 512); \
        _Pragma("unroll") for (int dt = 0; dt < 2; ++dt) _Pragma("unroll") for (int s_ = 0; s_ < 2; ++s_) VF[dt][s_] = *(const bf16x8*)(vp_ + (dt * 2 + s_) * 512); } while (0)
    ATT_LOAD(kf, vf, kt_lo);
    for (int kt = kt_lo; kt < kt_hi; ++kt) {
        bf16x8 kn[4], vn[2][2];
        { const int kk = (kt + 1 < kt_hi) ? kt + 1 : kt; ATT_LOAD(kn, vn, kk); }
        const bool need_mask = (kt + 1) * 32 > nkeys;
#pragma unroll
        for (int qt = 0; qt < NQT; ++qt) {
            f32x16 s;
            { const float c0 = bconst;
#pragma unroll
              for (int r = 0; r < 16; ++r) s[r] = c0; }
#pragma unroll
            for (int d0 = 0; d0 < 4; ++d0) s = MFMA32(kf[d0], qf[qt][d0], s);
            const int i = qt * 32 + x;
            if (kt >= 12) {
#pragma unroll
                for (int r = 0; r < 16; ++r) { const int j = kt * 32 + 16 * (r >> 3) + 8 * hi + (r & 7); s[r] += bias[i - j + 640]; }
            }
            if (need_mask) {
#pragma unroll
                for (int r = 0; r < 16; ++r) { const int j = kt * 32 + 16 * (r >> 3) + 8 * hi + (r & 7); if (j >= nkeys) s[r] = -1e30f; }
            }
            float mx = s[0];
#pragma unroll
            for (int r = 1; r < 16; ++r) mx = fmaxf(mx, s[r]);
            mx = xhalf_max(mx);
            const float mnew = fmaxf(mrow[qt], mx); const float alpha = __builtin_amdgcn_exp2f(mrow[qt] - mnew);
            float rs = 0.f;
#pragma unroll
            for (int r = 0; r < 16; ++r) { s[r] = __builtin_amdgcn_exp2f(s[r] - mnew); rs += s[r]; }
            rs = xhalf_sum(rs);
            lrow[qt] = lrow[qt] * alpha + rs; mrow[qt] = mnew;
            if (__any(alpha != 1.f)) {
#pragma unroll
                for (int r = 0; r < 16; ++r) { o[qt][0][r] *= alpha; o[qt][1][r] *= alpha; }
            }
            const bf16x8 p0 = pack8(s, 0), p1 = pack8(s, 8);
#pragma unroll
            for (int dt = 0; dt < 2; ++dt) { o[qt][dt] = MFMA32(vf[dt][0], p0, o[qt][dt]); o[qt][dt] = MFMA32(vf[dt][1], p1, o[qt][dt]); }
        }
#pragma unroll
        for (int d0 = 0; d0 < 4; ++d0) kf[d0] = kn[d0];
#pragma unroll
        for (int dt = 0; dt < 2; ++dt) { vf[dt][0] = vn[dt][0]; vf[dt][1] = vn[dt][1]; }
    }
#undef ATT_LOAD
#pragma unroll
    for (int qt = 0; qt < NQT; ++qt) {
        const float inv = 1.f / lrow[qt]; const int q = qt * 32 + x;
        if (q < qvalid) {
#pragma unroll
            for (int dt = 0; dt < 2; ++dt)
#pragma unroll
                for (int r4 = 0; r4 < 4; ++r4) {
                    u32x2 w; w.x = pk2(o[qt][dt][4 * r4 + 0] * inv, o[qt][dt][4 * r4 + 1] * inv); w.y = pk2(o[qt][dt][4 * r4 + 2] * inv, o[qt][dt][4 * r4 + 3] * inv);
                    *(u32x2*)(Op + (size_t)q * 1024 + dt * 32 + 8 * r4 + 4 * hi) = w;
                }
        }
    }
}

template <int NQT>
__device__ __forceinline__ bool attn_unit_fast(const bf16_t* Qp, int qvalid, const bf16_t* Kp, const bf16_t* Vtp, int kt_lo, int kt_hi, int nkeys,
                                               const LAS float* bias, float bconst, bf16_t* Op, int lane_) {
    int lane = lane_; asm volatile("" : "+v"(lane));
    const int x = lane & 31, hi = lane >> 5;
    bf16x8 qf[NQT][4];
#pragma unroll
    for (int qt = 0; qt < NQT; ++qt) { int qr = qt * 32 + x; if (qr >= qvalid) qr = qvalid - 1;
#pragma unroll
        for (int d0 = 0; d0 < 4; ++d0) qf[qt][d0] = *(const bf16x8*)(Qp + (size_t)qr * 1024 + d0 * 16 + hi * 8); }
    bf16x8 kf[4];
#define ATT_LOADK(KF, kk) do { const bf16_t* kp_ = Kp + (long)(kk) * 2048 + lane * 8; \
        _Pragma("unroll") for (int d0 = 0; d0 < 4; ++d0) KF[d0] = *(const bf16x8*)(kp_ + d0 * 512); } while (0)
#define ATT_LOADV(VF, kk) do { const bf16_t* vp_ = Vtp + (long)(kk) * 2048 + lane * 8; \
        _Pragma("unroll") for (int dt = 0; dt < 2; ++dt) _Pragma("unroll") for (int s_ = 0; s_ < 2; ++s_) VF[dt][s_] = *(const bf16x8*)(vp_ + (dt * 2 + s_) * 512); } while (0)
    ATT_LOADK(kf, kt_lo);
    f32x16 negm; float lsum[NQT]; f32x16 o[NQT][2];
    {
        float mxs = -1e30f;
#pragma unroll
        for (int qt = 0; qt < NQT; ++qt) {
            f32x16 s = f32x16{};
#pragma unroll
            for (int d0 = 0; d0 < 4; ++d0) s = MFMA32(kf[d0], qf[qt][d0], s);
            const int i = qt * 32 + x;
            if (kt_lo >= 12) {
#pragma unroll
                for (int r = 0; r < 16; ++r) { const int j = kt_lo * 32 + 16 * (r >> 3) + 8 * hi + (r & 7); s[r] += bias[i - j + 640]; }
            }
            float mx = s[0];
#pragma unroll
            for (int r = 1; r < 16; ++r) mx = fmaxf(mx, s[r]);
            mxs = fmaxf(mxs, xhalf_max(mx));
            lsum[qt] = 0.f; o[qt][0] = f32x16{}; o[qt][1] = f32x16{};
        }
#pragma unroll
        for (int r = 0; r < 16; ++r) negm[r] = -mxs;
        asm volatile("" : "+v"(negm));
    }
    for (int kt = kt_lo; kt < kt_hi; ++kt) {
        bf16x8 kn[4], vf[2][2];
        ATT_LOADV(vf, kt);
        { const int kk = (kt + 1 < kt_hi) ? kt + 1 : kt; ATT_LOADK(kn, kk); }
        const bool need_mask = (kt + 1) * 32 > nkeys;
        f32x16 sa[NQT], sb[NQT];
#pragma unroll
        for (int qt = 0; qt < NQT; ++qt) { sa[qt] = MFMA32(kf[0], qf[qt][0], negm); sb[qt] = MFMA32(kf[1], qf[qt][1], f32x16{}); }
#pragma unroll
        for (int qt = 0; qt < NQT; ++qt) { sa[qt] = MFMA32(kf[2], qf[qt][2], sa[qt]); sb[qt] = MFMA32(kf[3], qf[qt][3], sb[qt]); }
#pragma unroll
        for (int qt = 0; qt < NQT; ++qt) {
            f32x16 s = sa[qt] + sb[qt];
            const int i = qt * 32 + x;
            if (kt >= 12) {
#pragma unroll
                for (int r = 0; r < 16; ++r) { const int j = kt * 32 + 16 * (r >> 3) + 8 * hi + (r & 7); s[r] += bias[i - j + 640]; }
            }
            if (need_mask) {
#pragma unroll
                for (int r = 0; r < 16; ++r) { const int j = kt * 32 + 16 * (r >> 3) + 8 * hi + (r & 7); if (j >= nkeys) s[r] = -1e30f; }
            }
#pragma unroll
            for (int r = 0; r < 16; ++r) s[r] = __builtin_amdgcn_exp2f(s[r]);
            lsum[qt] += ((s[0] + s[1]) + (s[2] + s[3])) + ((s[4] + s[5]) + (s[6] + s[7])) + (((s[8] + s[9]) + (s[10] + s[11])) + ((s[12] + s[13]) + (s[14] + s[15])));
            const bf16x8 p0 = pack8(s, 0), p1 = pack8(s, 8);
#pragma unroll
            for (int dt = 0; dt < 2; ++dt) { o[qt][dt] = MFMA32(vf[dt][0], p0, o[qt][dt]); o[qt][dt] = MFMA32(vf[dt][1], p1, o[qt][dt]); }
        }
#pragma unroll
        for (int d0 = 0; d0 < 4; ++d0) kf[d0] = kn[d0];
    }
#undef ATT_LOADK
#undef ATT_LOADV
    bool bad = false; float inv[NQT];
#pragma unroll
    for (int qt = 0; qt < NQT; ++qt) { const float l = xhalf_sum(lsum[qt]); bad = bad || !(l > 1e-30f && l < 1e30f); inv[qt] = 1.f / l; }
    if (__any(bad)) return false;
#pragma unroll
    for (int qt = 0; qt < NQT; ++qt) {
        const int q = qt * 32 + x;
        if (q < qvalid) {
#pragma unroll
            for (int dt = 0; dt < 2; ++dt)
#pragma unroll
                for (int r4 = 0; r4 < 4; ++r4) {
                    u32x2 w; w.x = pk2(o[qt][dt][4 * r4 + 0] * inv[qt], o[qt][dt][4 * r4 + 1] * inv[qt]); w.y = pk2(o[qt][dt][4 * r4 + 2] * inv[qt], o[qt][dt][4 * r4 + 3] * inv[qt]);
                    *(u32x2*)(Op + (size_t)q * 1024 + dt * 32 + 8 * r4 + 4 * hi) = w;
                }
        }
    }
    return true;
}
__device__ __forceinline__ void gate_unit(bf16_t* Qg, bf16_t* Kg, const float* GL, bf16_t* keT, long T, float* DECp, const float* wup, const float* bgk, int nvalid, int lane_) {
    int lane = lane_; asm volatile("" : "+v"(lane));
    const int ch = 2 * lane;
    float w0[16], w1[16];
#pragma unroll
    for (int r = 0; r < 16; ++r) { w0[r] = wup[r * 512 + ch]; w1[r] = wup[r * 512 + ch + 1]; }
    const float b0 = bgk[ch], b1 = bgk[ch + 1];
    float s0 = 0.f, s1 = 0.f;
    const float SC = 0.08838834764831845f;
    const int ng = (nvalid + 7) >> 3;
    for (int t8 = ng; t8 < 8; ++t8) { *(u32x4*)(keT + (long)ch * T + t8 * 8) = u32x4{0u, 0u, 0u, 0u}; *(u32x4*)(keT + (long)(ch + 1) * T + t8 * 8) = u32x4{0u, 0u, 0u, 0u}; }
    for (int t8 = 0; t8 < ng; ++t8) {
        unsigned ka[4], kb[4];
#pragma unroll
        for (int tt = 0; tt < 8; ++tt) {
            const int t = t8 * 8 + tt;
            const float* gl = GL + t * 16;
            float z0 = b0, z1 = b1;
#pragma unroll
            for (int r = 0; r < 16; ++r) { const float gv = gl[r]; z0 += gv * w0[r]; z1 += gv * w1[r]; }
            const float g0 = -(fmaxf(-z0, 0.f) + __logf(1.f + __expf(-fabsf(z0)))) * (1.f / 16.f);
            const float g1 = -(fmaxf(-z1, 0.f) + __logf(1.f + __expf(-fabsf(z1)))) * (1.f / 16.f);
            if (t < nvalid) { s0 += g0; s1 += g1; }
            const unsigned q2 = *(const unsigned*)(Qg + (size_t)t * 512 + ch), k2 = *(const unsigned*)(Kg + (size_t)t * 512 + ch);
            const float e0 = __builtin_amdgcn_exp2f(s0 * LOG2E), e1 = __builtin_amdgcn_exp2f(s1 * LOG2E);
            const float i0 = __builtin_amdgcn_exp2f(-s0 * LOG2E), i1 = __builtin_amdgcn_exp2f(-s1 * LOG2E);
            *(unsigned*)(Qg + (size_t)t * 512 + ch) = pk2(bflo(q2) * SC * e0, bfhi(q2) * SC * e1);
            const unsigned kk = pk2(bflo(k2) * i0, bfhi(k2) * i1);
            *(unsigned*)(Kg + (size_t)t * 512 + ch) = kk;
            if (tt & 1) { ka[tt >> 1] |= (kk & 0xffffu) << 16; kb[tt >> 1] |= (kk & 0xffff0000u); }
            else { ka[tt >> 1] = kk & 0xffffu; kb[tt >> 1] = kk >> 16; }
        }
        u32x4 wa, wb; wa.x = ka[0]; wa.y = ka[1]; wa.z = ka[2]; wa.w = ka[3]; wb.x = kb[0]; wb.y = kb[1]; wb.z = kb[2]; wb.w = kb[3];
        *(u32x4*)(keT + (long)ch * T + t8 * 8) = wa; *(u32x4*)(keT + (long)(ch + 1) * T + t8 * 8) = wb;
    }
    DECp[ch] = __builtin_amdgcn_exp2f(s0 * LOG2E); DECp[ch + 1] = __builtin_amdgcn_exp2f(s1 * LOG2E);
}

__device__ __forceinline__ void gate_unit_p(const bf16_t* Qg, const bf16_t* Kg, bf16_t* Qo, bf16_t* Ko, const float* GL, bf16_t* keT, long T, float* DECp, const float* wup, const float* bgk, int nvalid, int lane_) {
    int lane = lane_; asm volatile("" : "+v"(lane));
    const int ch = 2 * lane;
    float w0[16], w1[16];
#pragma unroll
    for (int r = 0; r < 16; ++r) { w0[r] = wup[r * 512 + ch]; w1[r] = wup[r * 512 + ch + 1]; }
    const float b0 = bgk[ch], b1 = bgk[ch + 1];
    float s0 = 0.f, s1 = 0.f;
    const float SC = 0.08838834764831845f;
    for (int t8 = 0; t8 < 8; ++t8) {
        unsigned ka[4], kb[4];
#pragma unroll
        for (int tt = 0; tt < 8; ++tt) {
            const int t = t8 * 8 + tt;
            const float* gl = GL + t * 16;
            float z0 = b0, z1 = b1;
#pragma unroll
            for (int r = 0; r < 16; ++r) { const float gv = gl[r]; z0 += gv * w0[r]; z1 += gv * w1[r]; }
            const float g0 = -(fmaxf(-z0, 0.f) + __logf(1.f + __expf(-fabsf(z0)))) * (1.f / 16.f);
            const float g1 = -(fmaxf(-z1, 0.f) + __logf(1.f + __expf(-fabsf(z1)))) * (1.f / 16.f);
            if (t < nvalid) { s0 += g0; s1 += g1; }
            const unsigned q2 = *(const unsigned*)(Qg + (size_t)t * 512 + ch), k2 = *(const unsigned*)(Kg + (size_t)t * 512 + ch);
            const float e0 = __builtin_amdgcn_exp2f(s0 * LOG2E), e1 = __builtin_amdgcn_exp2f(s1 * LOG2E);
            const float i0 = __builtin_amdgcn_exp2f(-s0 * LOG2E), i1 = __builtin_amdgcn_exp2f(-s1 * LOG2E);
            *(unsigned*)(Qo + (size_t)t * 512 + ch) = pk2(bflo(q2) * SC * e0, bfhi(q2) * SC * e1);
            const unsigned kk = pk2(bflo(k2) * i0, bfhi(k2) * i1);
            *(unsigned*)(Ko + (size_t)t * 512 + ch) = kk;
            if (tt & 1) { ka[tt >> 1] |= (kk & 0xffffu) << 16; kb[tt >> 1] |= (kk & 0xffff0000u); }
            else { ka[tt >> 1] = kk & 0xffffu; kb[tt >> 1] = kk >> 16; }
        }
        u32x4 wa, wb; wa.x = ka[0]; wa.y = ka[1]; wa.z = ka[2]; wa.w = ka[3]; wb.x = kb[0]; wb.y = kb[1]; wb.z = kb[2]; wb.w = kb[3];
        *(u32x4*)(keT + (long)ch * T + t8 * 8) = wa; *(u32x4*)(keT + (long)(ch + 1) * T + t8 * 8) = wb;
    }
    DECp[ch] = __builtin_amdgcn_exp2f(s0 * LOG2E); DECp[ch + 1] = __builtin_amdgcn_exp2f(s1 * LOG2E);
}

template <bool EMIT>
__device__ __forceinline__ void gla_unit(const bf16_t* Qg, const bf16_t* Kg, const bf16_t* keT, const bf16_t* Vt, long T, const bf16_t* Rg, bf16_t* OG, const float* DECp,
                                         const float* gain, const float* Sin, float* Sout, int nsteps, int nvalid, LAS unsigned char* sm, int w, int lane_) {
    int lane = lane_; asm volatile("" : "+v"(lane));
    const int x = lane & 31, hi = lane >> 5; const int sx = (x & 0x13) | ((x & 4) << 1) | ((x & 8) >> 1);
    const int t = w * 64 + lane;
    LAS float* red = (LAS float*)sm;
    constexpr int QC = 4096, KC = QC + 64 * 272, TC = KC + 64 * 272;
    const bf16_t* gq = EMIT ? Qg + (size_t)(t >> 4) * 512 + (t & 15) * 8 : nullptr;
    const bf16_t* gk = EMIT ? Kg + (size_t)(t >> 4) * 512 + (t & 15) * 8 : nullptr;
    const bf16_t* gt = keT + (long)(t >> 3) * T + (t & 7) * 8;
    const int lq = (t >> 4) * 272 + (t & 15) * 16, lt = (t >> 3) * 144 + (t & 7) * 16;
    u32x4 stq[2], stk[2], stt[2];
#define GLA_GLOAD(kk) do { const int tk_ = 64 * (kk); \
        if (EMIT) { stq[0] = *(const u32x4*)(gq + (size_t)tk_ * 512); stq[1] = *(const u32x4*)(gq + (size_t)(tk_ + 32) * 512); \
                    stk[0] = *(const u32x4*)(gk + (size_t)tk_ * 512); stk[1] = *(const u32x4*)(gk + (size_t)(tk_ + 32) * 512); } \
        stt[0] = *(const u32x4*)(gt + tk_); stt[1] = *(const u32x4*)(gt + 64 * T + tk_); } while (0)
    f32x16 S[4];
    if (Sin) {
        const float* sp = Sin + (size_t)(8 * hi) * 256 + x;
#pragma unroll
        for (int dt = 0; dt < 4; ++dt) {
#pragma unroll
            for (int r = 0; r < 16; ++r) S[dt][r] = sp[(32 * dt + 16 * (r >> 3) + (r & 7)) * 256];
            asm volatile("" ::: "memory");
        }
    } else {
#pragma unroll
        for (int dt = 0; dt < 4; ++dt) S[dt] = f32x16{};
    }
    GLA_GLOAD(0);
    for (int k = 0; k < nsteps; ++k) {
        const int tk = 64 * k;
        __syncthreads();
        if (EMIT) { *(LAS u32x4*)(sm + QC + lq) = stq[0]; *(LAS u32x4*)(sm + QC + 32 * 272 + lq) = stq[1]; *(LAS u32x4*)(sm + KC + lq) = stk[0]; *(LAS u32x4*)(sm + KC + 32 * 272 + lq) = stk[1]; }
        *(LAS u32x4*)(sm + TC + lt) = stt[0]; *(LAS u32x4*)(sm + TC + 64 * 144 + lt) = stt[1];
        bf16x8 vf[2][2];
#pragma unroll
        for (int jt = 0; jt < 2; ++jt)
#pragma unroll
            for (int s = 0; s < 2; ++s) vf[jt][s] = *(const bf16x8*)(Vt + (long)x * T + tk + 32 * jt + 16 * s + 8 * hi);
        __syncthreads();
        if (!EMIT) { if (k + 1 < nsteps) GLA_GLOAD(k + 1); }
        f32x16 o0 = f32x16{}, o1 = f32x16{};
        if (EMIT) {
            const LAS unsigned char* q0p = sm + QC + x * 272 + hi * 16; const LAS unsigned char* q1p = q0p + 32 * 272;
            const LAS unsigned char* k0p = sm + KC + sx * 272 + hi * 16; const LAS unsigned char* k1p = k0p + 32 * 272;
            bf16x8 a00_0, a00_1, a01_0, a01_1, a11_0, a11_1;
            {
                f32x16 at00 = f32x16{}, at01 = f32x16{}, at11 = f32x16{};
#pragma unroll
                for (int ds = 0; ds < 8; ++ds) {
                    const bf16x8 q0 = *(const LAS bf16x8*)(q0p + 32 * ds), q1 = *(const LAS bf16x8*)(q1p + 32 * ds);
                    const bf16x8 k0 = *(const LAS bf16x8*)(k0p + 32 * ds), k1 = *(const LAS bf16x8*)(k1p + 32 * ds);
                    at00 = MFMA32(k0, q0, at00); at01 = MFMA32(k0, q1, at01); at11 = MFMA32(k1, q1, at11);
                }
#pragma unroll
                for (int r = 0; r < 16; ++r) { const int j = 16 * (r >> 3) + 8 * hi + (r & 7); if (j > x) { at00[r] = 0.f; at11[r] = 0.f; } }
                a00_0 = pack8(at00, 0); a00_1 = pack8(at00, 8); a01_0 = pack8(at01, 0); a01_1 = pack8(at01, 8); a11_0 = pack8(at11, 0); a11_1 = pack8(at11, 8);
            }
            asm volatile("" : "+v"(a00_0), "+v"(a00_1), "+v"(a01_0), "+v"(a01_1), "+v"(a11_0), "+v"(a11_1));
            if (k + 1 < nsteps) GLA_GLOAD(k + 1);
#pragma unroll
            for (int ds = 0; ds < 8; ++ds) {
                const bf16x8 q0 = *(const LAS bf16x8*)(q0p + 32 * ds), q1 = *(const LAS bf16x8*)(q1p + 32 * ds);
                const bf16x8 sb = pack8(S[ds >> 1], (ds & 1) * 8); o0 = MFMA32(sb, q0, o0); o1 = MFMA32(sb, q1, o1);
            }
            o0 = MFMA32(vf[0][0], a00_0, o0); o0 = MFMA32(vf[0][1], a00_1, o0);
            o1 = MFMA32(vf[0][0], a01_0, o1); o1 = MFMA32(vf[0][1], a01_1, o1);
            o1 = MFMA32(vf[1][0], a11_0, o1); o1 = MFMA32(vf[1][1], a11_1, o1);
        }
#pragma unroll
        for (int dt = 0; dt < 4; ++dt) {
            const LAS unsigned char* tp = sm + TC + (32 * dt + sx) * 144 + hi * 16;
            const float* dp = DECp + (size_t)k * 512 + 32 * dt + 8 * hi;
            float dc[16];
#pragma unroll
            for (int r = 0; r < 16; ++r) dc[r] = dp[16 * (r >> 3) + (r & 7)];
            f32x16 acc = S[dt];
#pragma unroll
            for (int jt = 0; jt < 2; ++jt)
#pragma unroll
                for (int s = 0; s < 2; ++s) { const bf16x8 kf = *(const LAS bf16x8*)(tp + 64 * jt + 32 * s); acc = MFMA32(kf, vf[jt][s], acc); }
#pragma unroll
            for (int r = 0; r < 16; ++r) S[dt][r] = acc[r] * dc[r];
        }
        if (EMIT) {
            float ss0 = 0.f, ss1 = 0.f;
#pragma unroll
            for (int r = 0; r < 16; ++r) { ss0 += o0[r] * o0[r]; ss1 += o1[r] * o1[r]; }
            ss0 = xhalf_sum(ss0); ss1 = xhalf_sum(ss1);
            LAS float* rp = red + (k & 1) * 512;
            if (hi == 0) { rp[w * 64 + x] = ss0; rp[w * 64 + 32 + x] = ss1; }
            __syncthreads();
            float t0 = 0.f, t1 = 0.f;
#pragma unroll
            for (int ww = 0; ww < 8; ++ww) { t0 += rp[ww * 64 + x]; t1 += rp[ww * 64 + 32 + x]; }
            const float r0 = 1.f / sqrtf(t0 * (1.f / 256.f) + GN_EPS), r1 = 1.f / sqrtf(t1 * (1.f / 256.f) + GN_EPS);
#pragma unroll
            for (int it = 0; it < 2; ++it) {
                const int i = 32 * it + x; const float rs = it ? r1 : r0;
                if (i < nvalid) {
#pragma unroll
                    for (int r4 = 0; r4 < 4; ++r4) {
                        const int vc = 8 * r4 + 4 * hi;
                        const f32x4 gg = *(const f32x4*)(gain + vc);
                        const u32x2 rr = *(const u32x2*)(Rg + (size_t)(tk + i) * 1024 + vc);
                        const f32x16& oo = it ? o1 : o0;
                        u32x2 wv; wv.x = pk2(oo[4 * r4 + 0] * rs * gg[0] * silu_f(bflo(rr.x)), oo[4 * r4 + 1] * rs * gg[1] * silu_f(bfhi(rr.x)));
                        wv.y = pk2(oo[4 * r4 + 2] * rs * gg[2] * silu_f(bflo(rr.y)), oo[4 * r4 + 3] * rs * gg[3] * silu_f(bfhi(rr.y)));
                        *(u32x2*)(OG + (size_t)(tk + i) * 1024 + vc) = wv;
                    }
                }
            }
        }
    }
#undef GLA_GLOAD
    if (Sout) {
        float* sp = Sout + (size_t)(8 * hi) * 256 + x;
#pragma unroll
        for (int dt = 0; dt < 4; ++dt) {
#pragma unroll
            for (int r = 0; r < 16; ++r) sp[(32 * dt + 16 * (r >> 3) + (r & 7)) * 256] = S[dt][r];
            asm volatile("" ::: "memory");
        }
    }
}

#define XB_TMO      128
#define XB_XCNT(j)  (256  + 64 * (j))
#define XB_XSUB(j)  (1280 + 64 * (j))
#define XB_XGEN(j)  (2304 + 64 * (j))
#define XB_TOP      3328
#define XB_TOPGEN   3392
#define XCD_BAR_WORDS 3456
#define XB_SPIN_CAP (1u << 18)

__device__ __forceinline__ unsigned xb_ld(unsigned* p)              { return __hip_atomic_load(p, __ATOMIC_RELAXED, __HIP_MEMORY_SCOPE_AGENT); }
__device__ __forceinline__ unsigned xb_add(unsigned* p, unsigned v) { return __hip_atomic_fetch_add(p, v, __ATOMIC_RELAXED, __HIP_MEMORY_SCOPE_AGENT); }
__device__ __forceinline__ unsigned xb_xcc_id() { return (unsigned)__builtin_amdgcn_s_getreg((3 << 11) | 20) & 0xFu; }
#define XB_SPIN(cond, bar) do { unsigned _sp = 0; while (cond) { __builtin_amdgcn_s_sleep(1); \
    if ((++_sp & 255u) == 0u) { if (xb_ld(&(bar)[XB_TMO])) break; if (_sp > XB_SPIN_CAP) { atomicAdd(&(bar)[XB_TMO], 1u); break; } } } } while (0)

struct XcdBarrier {
    unsigned* bar; unsigned x;
    volatile LAS unsigned* st;
};

__device__ __forceinline__ XcdBarrier xcd_barrier_post(unsigned* bar, volatile LAS unsigned* st) {
    XcdBarrier b; b.bar = bar; b.x = xb_xcc_id(); b.st = st;
    if (threadIdx.x == 0) (void)xb_add(&bar[XB_XCNT(b.x)], 1u);
    return b;
}
__device__ __forceinline__ void xcd_barrier_complete(unsigned* bar, unsigned x, unsigned& nloc, unsigned& nx) {
    const unsigned G = gridDim.x * gridDim.y * gridDim.z;
    unsigned sum, cnt, mine, sp = 0u;
    for (;;) {
        sum = 0u; cnt = 0u; mine = 0u;
#pragma unroll
        for (unsigned j = 0; j < 16; ++j) { const unsigned c = xb_ld(&bar[XB_XCNT(j)]); sum += c; cnt += (c > 0u) ? 1u : 0u; }
        mine = xb_ld(&bar[XB_XCNT(x)]);
        if (sum == G) break;
        __builtin_amdgcn_s_sleep(1);
        if ((++sp & 255u) == 0u) { if (xb_ld(&bar[XB_TMO])) break; if (sp > XB_SPIN_CAP) { atomicAdd(&bar[XB_TMO], 1u); break; } }
    }
    nloc = mine > 0u ? mine : 1u; nx = cnt > 0u ? cnt : 1u;
}

__device__ __forceinline__ void xcd_barrier(const XcdBarrier& b) {
    asm volatile("s_waitcnt vmcnt(0)" ::: "memory");
    __syncthreads();
    if (threadIdx.x == 0) {
        unsigned* bar = b.bar;
        __builtin_amdgcn_s_waitcnt(0);
        unsigned nloc = b.st[0], nx = b.st[1];
        if (nloc == 0u) { xcd_barrier_complete(bar, b.x, nloc, nx); b.st[0] = nloc; b.st[1] = nx; }
        const unsigned old = xb_add(&bar[XB_XSUB(b.x)], 1u);
        const unsigned gen = old / nloc;
        if (old + 1u == (gen + 1u) * nloc) {
            __builtin_amdgcn_fence(__ATOMIC_RELEASE, "agent");
            asm volatile("s_waitcnt vmcnt(0)" ::: "memory");
            const unsigned og = xb_add(&bar[XB_TOP], 1u);
            const unsigned tg = og / nx;
            if (og + 1u == (tg + 1u) * nx) xb_add(&bar[XB_TOPGEN], 1u);
            else XB_SPIN(xb_ld(&bar[XB_TOPGEN]) == tg, bar);
            __builtin_amdgcn_fence(__ATOMIC_ACQUIRE, "agent");
            xb_add(&bar[XB_XGEN(b.x)], 1u);
            asm volatile("s_waitcnt vmcnt(0)" ::: "memory");
        } else {
            XB_SPIN(xb_ld(&bar[XB_XGEN(b.x)]) == gen, bar);
            __builtin_amdgcn_fence(__ATOMIC_ACQUIRE, "agent");
            asm volatile("s_waitcnt vmcnt(0)" ::: "memory");
        }
    }
    __syncthreads();
}

struct Args { const float* in[19]; float* out; unsigned char* ws; int lo, hi; };

template <class Epi, bool ATILED = false>
__device__ __forceinline__ void run_gemm(LAS unsigned char* lds, const bf16_t* A, const bf16_t* Bt, int M, int N, int K, const Epi& E, int G, int bid) {
    pg8::Gemm g{A, Bt, M, N, K}; pg8::StaticOrder S; S.init(M, N, G, bid);
    pg8::gemm_phase<Epi, pg8::StaticOrder, true, true, ATILED>(lds, g, S, E);
}

enum { IN_XP = 0, IN_XS, IN_CK, IN_CV, IN_SB, IN_WINA, IN_REL, IN_WOUTA, IN_WINB, IN_WGK, IN_BGK, IN_GN, IN_WOUTB, IN_WFI, IN_WFO, IN_L1G, IN_L1B, IN_L2G, IN_L2B };
constexpr int NPHASE = 18;
#ifndef MK_PHMASK
#define MK_PHMASK 0xFFFFFFFFu
#endif
#ifndef MK_REP_GEMM
#define MK_REP_GEMM 1
#endif
#ifndef MK_REP_SMALL
#define MK_REP_SMALL 1
#endif
#ifndef MK_REP_ATT
#define MK_REP_ATT 1
#endif
#ifndef MK_REP_GLA
#define MK_REP_GLA 1
#endif
#ifndef MK_REP_LN
#define MK_REP_LN 1
#endif
#define PH_OFF(k) ((((unsigned)MK_PHMASK) >> (k)) & 1u) == 0u

#define WINA ((bf16_t*)(ws + WS_WINA))
#define WOUTA ((bf16_t*)(ws + WS_WOUTA))
#define WINB ((bf16_t*)(ws + WS_WINB))
#define WOUTB ((bf16_t*)(ws + WS_WOUTB))
#define WFI ((bf16_t*)(ws + WS_WFI))
#define WFO ((bf16_t*)(ws + WS_WFO))
#define X ((bf16_t*)(ws + WS_X))
#define XS ((bf16_t*)(ws + WS_XS))
#define Q ((bf16_t*)(ws + WS_Q))
#define KB ((bf16_t*)(ws + WS_KB))
#define VT ((bf16_t*)(ws + WS_VT))
#define H ((bf16_t*)(ws + WS_H))
#define AO ((bf16_t*)(ws + WS_AO))
#define AOS ((bf16_t*)(ws + WS_AOS))
#define QS ((bf16_t*)(ws + WS_QS))
#define KSA ((bf16_t*)(ws + WS_KSA))
#define VTSA ((bf16_t*)(ws + WS_VTSA))
#define HS ((bf16_t*)(ws + WS_HS))
#define QG ((bf16_t*)(ws + WS_QG))
#define KG ((bf16_t*)(ws + WS_KG))
#define VT1 ((bf16_t*)(ws + WS_VT1))
#define RG ((bf16_t*)(ws + WS_RG))
#define GL ((float*)(ws + WS_GL))
#define KET ((bf16_t*)(ws + WS_KET))
#define OG ((bf16_t*)(ws + WS_OG))
#define TG ((float*)(ws + WS_TG))
#define DEC ((float*)(ws + WS_DEC))
#define PDG ((float*)(ws + WS_PDG))
#define QGS ((bf16_t*)(ws + WS_QGS))
#define KGS ((bf16_t*)(ws + WS_KGS))
#define VTS ((bf16_t*)(ws + WS_VTS))
#define RGS ((bf16_t*)(ws + WS_RGS))
#define GLS ((float*)(ws + WS_GLS))
#define KETS ((bf16_t*)(ws + WS_KETS))
#define DECS ((float*)(ws + WS_DECS))
#define OGS ((bf16_t*)(ws + WS_OGS))
#define PREA ((bf16_t*)(ws + ACT + 64 * MiB))
#define PREB ((bf16_t*)(ws + ACT + 192 * MiB))
#define PRES (out + O_YS)
#ifndef MK_VAR
#define MK_VAR 0
#endif
template <int PH, int VAR = 0>
__device__ __forceinline__ void do_phase(const Args& a, LAS unsigned char* lds, int wave0) {
    constexpr int ph = PH;
    typedef __attribute__((address_space(1))) unsigned char gu8_t; typedef __attribute__((address_space(1))) float gf32_t;
    unsigned long long wsi_ = (unsigned long long)a.ws, oui_ = (unsigned long long)a.out; asm volatile("" : "+s"(wsi_), "+s"(oui_));
    gu8_t* ws = (gu8_t*)wsi_; gf32_t* out_g = (gf32_t*)oui_;
#define out ((float*)out_g)
    int wave = wave0, bid = blockIdx.x, G = gridDim.x; asm volatile("" : "+s"(wave), "+s"(bid), "+s"(G));
    const int gw = bid * 8 + wave, ngw = G * 8; const size_t gthreads = (size_t)G * 512; (void)gw; (void)ngw; (void)gthreads;
#define PHASE_IDS() int tid = threadIdx.x; asm volatile("" : "+v"(tid)); const int lane = tid & 63; const size_t gtid = (size_t)bid * 512 + tid; (void)lane; (void)gtid;
        switch (ph) {
        case 0: { if constexpr (PH_OFF(0)) break; PHASE_IDS();
            LAS float* scr = (LAS float*)(lds + wave * 8704);
            constexpr int I0 = 16 * 96, I1 = 16 * 32, I2 = 16 * 97, I3 = 16 * 32, I4 = 16 * 176, I5 = 44 * 32;
            constexpr int NIT = I0 + I1 + I2 + I3 + 2 * I4 + 2 * I5;
            for (int it = gw; it < NIT; it += ngw) {
                int r = it;
                if (r < I0) { tr_item(a.in[IN_WINA], 1024, 3072, WINA, 0, scr, r, lane); continue; } r -= I0;
                if (r < I1) { tr_item(a.in[IN_WOUTA], 1024, 1024, WOUTA, 0, scr, r, lane); continue; } r -= I1;
                if (r < I2) { tr_item(a.in[IN_WINB], 1024, 3088, WINB, 0, scr, r, lane); continue; } r -= I2;
                if (r < I3) { tr_item(a.in[IN_WOUTB], 1024, 1024, WOUTB, 0, scr, r, lane); continue; } r -= I3;
                if (r < 2 * I4) { const int l = r / I4; tr_item(a.in[IN_WFI] + (size_t)l * 1024 * 5632, 1024, 5632, WFI + (size_t)l * 5632 * 1024, 1, scr, r - l * I4, lane); continue; } r -= 2 * I4;
                { const int l = r / I5; tr_item(a.in[IN_WFO] + (size_t)l * DFF * 1024, DFF, 1024, WFO + (size_t)l * 1024 * DFF, 0, scr, r - l * I5, lane); }
            }
            for (size_t e = gtid; e < (size_t)(NGLA - 3104) * 1024 / 8; e += gthreads) ((u32x4*)(WINB + (size_t)3104 * 1024))[e] = u32x4{0u, 0u, 0u, 0u};
            { const f32x4* src = (const f32x4*)a.in[IN_XP]; u32x2* dst = (u32x2*)X;
              for (size_t e = gtid; e < (size_t)MP * 1024 / 8; e += 4 * gthreads) { f32x4 v[4][2];
#pragma unroll
                  for (int q = 0; q < 4; ++q) { v[q][0] = src[2 * (e + q * gthreads)]; v[q][1] = src[2 * (e + q * gthreads) + 1]; }
#pragma unroll
                  for (int q = 0; q < 4; ++q) { u32x4 w; w.x = pk2(v[q][0][0], v[q][0][1]); w.y = pk2(v[q][0][2], v[q][0][3]); w.z = pk2(v[q][1][0], v[q][1][1]); w.w = pk2(v[q][1][2], v[q][1][3]);
                      ((u32x4*)dst)[e + q * gthreads] = w; } } }
            { const f32x4* src = (const f32x4*)a.in[IN_XS]; u32x2* dst = (u32x2*)XS;
              for (size_t e = gtid; e < (size_t)MS * 1024 / 4; e += gthreads) { const f32x4 v = src[e]; u32x2 w; w.x = pk2(v[0], v[1]); w.y = pk2(v[2], v[3]); dst[e] = w; } }
            { const f32x4* srck = (const f32x4*)a.in[IN_CK]; const f32x4* srcv = (const f32x4*)a.in[IN_CV];
              for (size_t e = gtid; e < (size_t)8 * 512 * 256; e += gthreads) { const int c = (int)(e & 255) * 4, j = (int)((e >> 8) & 511), bs = (int)(e >> 17);
                  const f32x4 kv = srck[e], vv = srcv[e];
                  u32x2 w; w.x = pk2(kv[0], kv[1]); w.y = pk2(kv[2], kv[3]); *(u32x2*)(KSA + kf_addr(bs * 16 + (c >> 6), 18, j, c & 63)) = w;
                  bf16_t* d2 = VTSA + vf_addr(bs * 16 + (c >> 6), 18, j, c & 63);
#pragma unroll
                  for (int q = 0; q < 4; ++q) d2[q * 8] = f2bf(vv[q]); }
              for (size_t e = gtid; e < (size_t)128 * 512; e += gthreads) { const int bh = (int)(e >> 9), o = (int)(e & 511) * 8;
                  *(u32x4*)(KSA + ((size_t)bh * 18 + 16) * 2048 + o) = u32x4{0u, 0u, 0u, 0u}; *(u32x4*)(VTSA + ((size_t)bh * 18 + 16) * 2048 + o) = u32x4{0u, 0u, 0u, 0u}; } }
            for (size_t e = gtid; e < (2 * MiB) / 16; e += gthreads) ((u32x4*)(ws + WS_QGS))[e] = u32x4{0u, 0u, 0u, 0u};
            for (size_t e = gtid; e < (32 * 1024) / 16; e += gthreads) ((u32x4*)(ws + WS_GLS))[e] = u32x4{0u, 0u, 0u, 0u};
        } break;
        case 1: { if constexpr (PH_OFF(1)) break; PHASE_IDS();
            EpiQKV E{Q, KB, VT, out + O_AKP, out + O_AVP};
            run_gemm(lds, X, WINA, MP, 2048, 1024, E, G, bid);
            { EpiVT<0> EV{VT, out + O_AVP}; run_gemm(lds, WINA + (size_t)2048 * 1024, X, 1024, MP, 1024, EV, G, bid); }
            SQkv SE{QS, KSA, VTSA, out + O_AKS, out + O_AVS};
            for (int rep_ = 0; rep_ < MK_REP_SMALL; ++rep_) { small_gemm<false>(XS, WINA, 1024, 96, (LAS float*)lds, wave, lane, SE); }
        } break;
        case 2: { if constexpr (PH_OFF(2)) break; PHASE_IDS();
            LAS float* lb = (LAS float*)lds;
            const float* rel = a.in[IN_REL];
            for (int e = tid; e < 320 * 16; e += 512) { const int idx = e >> 4, h = e & 15; const int ic = idx > 256 ? 256 : idx; lb[h * 324 + idx] = (rel[ic * 16 + h] - rel[256 * 16 + h]) * LOG2E; }
            __syncthreads();
            const bool xmap = (G == 256);
            const int nui = xmap ? 8 : (8192 + 128 + ngw - 1) / ngw;
            unsigned failmask = 0u;
#define ATT_UNIT_INDEX(ui, u) do { if (xmap) { const int lw = (bid >> 3) * 8 + wave, stream = (bid & 7) * 4 + (ui); \
        if ((ui) < 4) u = ((stream >> 4) << 12) | (lw << 4) | (stream & 15); \
        else { const int j_ = (ui) - 4, cnt_ = (0x00122344 >> (4 * wave)) & 15, st_ = wave == 0 ? 0 : wave == 1 ? 4 : wave == 2 ? 8 : wave == 3 ? 11 : wave == 4 ? 13 : wave == 5 ? 15 : 16; \
               u = (bid < 8 && j_ < cnt_) ? 8192 + bid * 16 + st_ + j_ : 1 << 30; } \
      } else u = gw + (ui) * ngw; } while (0)
            for (int ui = 0; ui < nui; ++ui) {
                int u; ATT_UNIT_INDEX(ui, u);
                if (u >= 8192 + 128) continue;
                bool ok;
                if (u < 8192) {
                    const int h = u & 15, c = (u >> 4) & 255, b = u >> 12; const long row0 = (long)b * 16384 + c * 64;
                    const long tile0 = (long)(b * 16 + h) * 512 + (2 * c - 16);
                    const int kt_lo = (16 - 2 * c) > 0 ? (16 - 2 * c) : 0;
                    ok = attn_unit_fast<2>(Q + row0 * 1024 + h * 64, 64, KB + tile0 * 2048, VT + tile0 * 2048, kt_lo, 18, 576, lb + h * 324, rel[256 * 16 + h] * LOG2E, AO + row0 * 1024 + h * 64, lane);
                } else {
                    const int su = u - 8192, h = su & 15, bs = su >> 4;
                    ok = attn_unit_fast<1>(QS + (size_t)bs * 16 * 1024 + h * 64, 16, KSA + (size_t)(bs * 16 + h) * 18 * 2048, VTSA + (size_t)(bs * 16 + h) * 18 * 2048, 0, 17, 528, lb + h * 324, rel[256 * 16 + h] * LOG2E,
                                           AOS + (size_t)bs * 16 * 1024 + h * 64, lane);
                }
                if (!ok) failmask |= 1u << (ui & 31);
            }
            asm volatile("" ::: "memory");
            if (failmask) {
                for (int ui = 0; ui < nui; ++ui) {
                    if (!((failmask >> (ui & 31)) & 1u)) continue;
                    int u; ATT_UNIT_INDEX(ui, u);
                    if (u >= 8192 + 128) continue;
                    if (u < 8192) {
                        const int h = u & 15, c = (u >> 4) & 255, b = u >> 12; const long row0 = (long)b * 16384 + c * 64;
                        const long tile0 = (long)(b * 16 + h) * 512 + (2 * c - 16);
                        const int kt_lo = (16 - 2 * c) > 0 ? (16 - 2 * c) : 0;
                        attn_unit_safe<2>(Q + row0 * 1024 + h * 64, 64, KB + tile0 * 2048, VT + tile0 * 2048, kt_lo, 18, 576, lb + h * 324, rel[256 * 16 + h] * LOG2E, AO + row0 * 1024 + h * 64, lane);
                    } else {
                        const int su = u - 8192, h = su & 15, bs = su >> 4;
                        attn_unit_safe<1>(QS + (size_t)bs * 16 * 1024 + h * 64, 16, KSA + (size_t)(bs * 16 + h) * 18 * 2048, VTSA + (size_t)(bs * 16 + h) * 18 * 2048, 0, 17, 528, lb + h * 324, rel[256 * 16 + h] * LOG2E,
                                          AOS + (size_t)bs * 16 * 1024 + h * 64, lane);
                    }
                }
            }
#undef ATT_UNIT_INDEX
            __syncthreads();
        } break;
        case 3: case 13: { if constexpr (PH_OFF(3)) break; PHASE_IDS();
            const bool l1 = (ph == 13);
            EpiRes E{X, PREA};
            for (int rep_ = 0; rep_ < MK_REP_GEMM; ++rep_) { run_gemm(lds, l1 ? OG : AO, l1 ? WOUTB : WOUTA, MP, 1024, 1024, E, G, bid); }
            SRes SE{XS, PRES};
            for (int rep_ = 0; rep_ < MK_REP_SMALL; ++rep_) { small_gemm<false>(l1 ? OGS : AOS, l1 ? WOUTB : WOUTA, 1024, 32, (LAS float*)lds, wave, lane, SE); }
        } break;
        case 4: case 7: case 14: case 17: { if constexpr (PH_OFF(4)) break; PHASE_IDS();
            const int layer = ph >= 14 ? 1 : 0; const bool second = (ph == 7 || ph == 17);
            const float* g = a.in[second ? IN_L2G : IN_L1G] + layer * 1024; const float* bt = a.in[second ? IN_L2B : IN_L1B] + layer * 1024;
            const bool fin = (ph == 17);
            if constexpr (ph == 4 || ph == 14) lnb_rows<8, true>(PREA, MP, g, bt, X, nullptr, gw, ngw, lane);
            else lnb_rows<8>(second ? PREB : PREA, MP, g, bt, fin ? nullptr : X, fin ? out + O_YP : nullptr, gw, ngw, lane);
            ln_rows(PRES, MS, g, bt, fin ? nullptr : XS, fin ? PRES : nullptr, gw, ngw, lane);
        } break;
        case 5: case 15: { if constexpr (PH_OFF(5)) break; PHASE_IDS();
            const int layer = ph == 15 ? 1 : 0; const bf16_t* W = WFI + (size_t)layer * 5632 * 1024;
            EpiSwi E{H};
            for (int rep_ = 0; rep_ < MK_REP_GEMM; ++rep_) { run_gemm<EpiSwi, true>(lds, X, W, MP, 5632, 1024, E, G, bid); }
            SSwi SE{HS};
            for (int rep_ = 0; rep_ < MK_REP_SMALL; ++rep_) { small_gemm<true>(XS, W, 1024, 88, (LAS float*)lds, wave, lane, SE); }
        } break;
        case 6: case 16: { if constexpr (PH_OFF(6)) break; PHASE_IDS();
            const int layer = ph == 16 ? 1 : 0; const bf16_t* W = WFO + (size_t)layer * 1024 * DFF;
            EpiResT<true> E{X, PREB};
            for (int rep_ = 0; rep_ < MK_REP_GEMM; ++rep_) { run_gemm<EpiResT<true>, true>(lds, H, W, MP, 1024, DFF, E, G, bid); }
            SRes SE{XS, PRES};
            for (int rep_ = 0; rep_ < MK_REP_SMALL; ++rep_) { small_gemm<false>(HS, W, DFF, 32, (LAS float*)lds, wave, lane, SE); }
        } break;
        case 8: { if constexpr (PH_OFF(8)) break; PHASE_IDS();
            EpiGla E{QG, KG, VT1, RG, GL};
            run_gemm(lds, X, WINB, MP, 1024, 1024, E, G, bid);
            { EpiGlaR ER{RG, GL}; run_gemm(lds, X, WINB + (size_t)2048 * 1024, MP, 1280, 1024, ER, G, bid); }
            { EpiVT<1> EV{VT1, nullptr}; run_gemm(lds, WINB + (size_t)1024 * 1024, X, 1024, MP, 1024, EV, G, bid); }
            SGla SE{QGS, KGS, VTS, RGS, GLS};
            for (int rep_ = 0; rep_ < MK_REP_SMALL; ++rep_) { small_gemm<false>(XS, WINB, 1024, 97, (LAS float*)lds, wave, lane, SE); }
        } break;
        case 9: { if constexpr (PH_OFF(9)) break; PHASE_IDS();
            const float* wup = a.in[IN_WGK]; const float* bgk = a.in[IN_BGK];
            for (int u = gw; u < 2048 + 32; u += ngw) {
                if (u < 2048) { const int h = u & 3, ck = u >> 2, b = ck >> 8; const size_t row0 = (size_t)ck * 64;
                    if (VAR) gate_unit_p(QG + row0 * 512 + h * 128, KG + row0 * 512 + h * 128, OG + row0 * 512 + h * 128, OG + (size_t)MP * 512 + row0 * 512 + h * 128, GL + row0 * 16, (bf16_t*)TG + (size_t)(b * 512 + h * 128) * 16384 + (ck & 255) * 64, 16384,
                              DEC + (size_t)ck * 512 + h * 128, wup + h * 128, bgk + h * 128, 64, lane);
                    else
                    gate_unit(QG + row0 * 512 + h * 128, KG + row0 * 512 + h * 128, GL + row0 * 16, KET + (size_t)(b * 512 + h * 128) * 16384 + (ck & 255) * 64, 16384,
                              DEC + (size_t)ck * 512 + h * 128, wup + h * 128, bgk + h * 128, 64, lane);
                } else if (!VAR) { const int su = u - 2048, h = su & 3, bs = su >> 2;
                    gate_unit(QGS + (size_t)bs * 64 * 512 + h * 128, KGS + (size_t)bs * 64 * 512 + h * 128, GLS + bs * 64 * 16, KETS + (size_t)(bs * 512 + h * 128) * 64, 64,
                              DECS + bs * 512 + h * 128, wup + h * 128, bgk + h * 128, 16, lane); }
            }
        } break;
        case 10: { if constexpr (PH_OFF(10)) break; PHASE_IDS();
            LAS unsigned char* red = lds;
            for (int rep_ = 0; rep_ < MK_REP_GLA; ++rep_)
            for (int u = bid; u < 256; u += G) {
                const int g = u & 31, bh = u >> 5, h = bh & 3, b = bh >> 2; const int ck0 = b * 256 + 8 * g;
                gla_unit<false>(nullptr, nullptr, KET + (size_t)(b * 512 + h * 128) * 16384 + 512 * g, VT1 + (size_t)(b * 1024 + h * 256 + 32 * wave) * 16384 + 512 * g, 16384, nullptr, nullptr,
                                DEC + (size_t)ck0 * 512 + h * 128, nullptr, nullptr, TG + (size_t)u * 32768 + 32 * wave, 8, 64, red, wave, lane);
                if (wave == 0) {
#pragma unroll
                    for (int q = 0; q < 2; ++q) { const int d = lane + 64 * q; float pd = 1.f;
#pragma unroll
                        for (int c = 0; c < 8; ++c) pd *= DEC[(size_t)(ck0 + c) * 512 + h * 128 + d];
                        PDG[u * 128 + d] = pd; }
                }
            }
        } break;
        case 12: { if constexpr (PH_OFF(12)) break; PHASE_IDS();
            LAS unsigned char* red = lds;
            const float* gain = a.in[IN_GN];
            for (int rep_ = 0; rep_ < MK_REP_GLA; ++rep_)
            for (int u = bid; u < 256; u += G) {
                const int g = u & 31, bh = u >> 5, h = bh & 3, b = bh >> 2; const int ck0 = b * 256 + 8 * g; const size_t row0 = (size_t)ck0 * 64;
                gla_unit<true>(QG + row0 * 512 + h * 128, KG + row0 * 512 + h * 128, KET + (size_t)(b * 512 + h * 128) * 16384 + 512 * g, VT1 + (size_t)(b * 1024 + h * 256 + 32 * wave) * 16384 + 512 * g, 16384,
                               RG + row0 * 1024 + h * 256 + 32 * wave, OG + row0 * 1024 + h * 256 + 32 * wave, DEC + (size_t)ck0 * 512 + h * 128, gain + h * 256 + 32 * wave,
                               TG + (size_t)u * 32768 + 32 * wave, g == 31 ? out + O_SBP + (size_t)bh * 32768 + 32 * wave : nullptr, 8, 64, red, wave, lane);
                __syncthreads();
            }
            asm volatile("" ::: "memory");
            for (int su = bid; su < 32; su += G) {
                const int h = su & 3, bs = su >> 2;
                gla_unit<true>(QGS + (size_t)bs * 64 * 512 + h * 128, KGS + (size_t)bs * 64 * 512 + h * 128, KETS + (size_t)(bs * 512 + h * 128) * 64, VTS + (size_t)(bs * 1024 + h * 256 + 32 * wave) * 64, 64,
                               RGS + (size_t)bs * 16 * 1024 + h * 256 + 32 * wave, OGS + (size_t)bs * 16 * 1024 + h * 256 + 32 * wave, DECS + bs * 512 + h * 128, gain + h * 256 + 32 * wave,
                               a.in[IN_SB] + (size_t)su * 32768 + 32 * wave, out + O_SBS + (size_t)su * 32768 + 32 * wave, 1, 16, red, wave, lane);
                __syncthreads();
            }
        } break;
        case 11: { if constexpr (PH_OFF(11)) break; PHASE_IDS();
            for (size_t e = gtid; e < 262144; e += gthreads) {
                const int bh = (int)(e >> 15), dv = (int)(e & 32767), d = dv >> 8;
                float t[32], pd[32];
#pragma unroll
                for (int g = 0; g < 32; ++g) { t[g] = TG[((size_t)bh * 32 + g) * 32768 + dv]; pd[g] = PDG[(bh * 32 + g) * 128 + d]; }
                float S = 0.f;
#pragma unroll
                for (int g = 0; g < 32; ++g) { (VAR ? (float*)OG : TG)[((size_t)bh * 32 + g) * 32768 + dv] = S; S = pd[g] * S + t[g]; }
            }
        } break;
        default: break;
        }
#undef out
}

#ifndef MK_DUP
#define MK_DUP (-1)
#endif
__global__ void __launch_bounds__(512, 2) mk_fwd(Args a) {
    extern __shared__ __attribute__((aligned(16))) unsigned char lds_raw[];
    LAS unsigned char* lds = (LAS unsigned char*)lds_raw;
    const int wave0 = __builtin_amdgcn_readfirstlane((int)threadIdx.x >> 6);
    cg::grid_group grid = cg::this_grid();
    volatile LAS unsigned* bst = (volatile LAS unsigned*)(lds + 131072);
    if (threadIdx.x < 64) bst[threadIdx.x] = 0u;
    __syncthreads();
    XcdBarrier xbar = xcd_barrier_post((unsigned*)a.ws, bst);
    if (a.lo < 0) grid.sync();
#define SEAM(k) do { if ((k) + 1 < a.hi) xcd_barrier(xbar); } while (0)
#define PHASE(k) do { if (a.lo <= (k) && (k) < a.hi) { do_phase<k>(a, lds, wave0); if (MK_DUP == (k)) { xcd_barrier(xbar); do_phase<k, MK_VAR>(a, lds, wave0); } SEAM(k); } } while (0)
    PHASE(0); PHASE(1); PHASE(2); PHASE(3); PHASE(4); PHASE(5); PHASE(6); PHASE(7); PHASE(8); PHASE(9);
    PHASE(10); PHASE(11); PHASE(12); PHASE(13); PHASE(14); PHASE(15); PHASE(16); PHASE(17);
#undef PHASE
#undef SEAM
}
#undef WINA
#undef WOUTA
#undef WINB
#undef WOUTB
#undef WFI
#undef WFO
#undef X
#undef XS
#undef Q
#undef KB
#undef VT
#undef H
#undef AO
#undef AOS
#undef QS
#undef KSA
#undef VTSA
#undef HS
#undef QG
#undef KG
#undef VT1
#undef RG
#undef GL
#undef KET
#undef OG
#undef TG
#undef DEC
#undef PDG
#undef QGS
#undef KGS
#undef VTS
#undef RGS
#undef GLS
#undef KETS
#undef DECS
#undef OGS
#undef PREA
#undef PREB
#undef PRES
extern "C" void kernel_launch(void* const* d_in, const int* in_sizes, int n_in, void* d_out, int out_size, void* d_ws, size_t ws_size, hipStream_t stream) {
    static int grid = 0;
    if (grid == 0) {
        int dev = 0, cus = 0, per_cu = 0;
        (void)hipGetDevice(&dev); (void)hipDeviceGetAttribute(&cus, hipDeviceAttributeMultiprocessorCount, dev);
        (void)hipFuncSetAttribute((const void*)mk_fwd, hipFuncAttributeMaxDynamicSharedMemorySize, LDS_BYTES);
        (void)hipOccupancyMaxActiveBlocksPerMultiprocessor(&per_cu, (const void*)mk_fwd, 512, LDS_BYTES);
        if (per_cu < 1) per_cu = 1;
        grid = cus * 1;
        if (grid <= 0) grid = 256;
    }
    Args a{};
    for (int i = 0; i < 19; ++i) a.in[i] = (const float*)d_in[i];
    a.out = (float*)d_out; a.ws = (unsigned char*)d_ws;
    (void)hipMemsetAsync(d_ws, 0, 65536, stream);
#if MK_MULTI
    for (int ph = 0; ph < NPHASE; ++ph) { a.lo = ph; a.hi = ph + 1; hipLaunchKernelGGL(mk_fwd, dim3(grid), dim3(512), LDS_BYTES, stream, a); }
#else
    a.lo = 0; a.hi = NPHASE;
    void* args[] = {&a};
    (void)hipLaunchCooperativeKernel((const void*)mk_fwd, dim3(grid), dim3(512), args, LDS_BYTES, stream);
#endif
}
```

```cpp
#include <hip/hip_runtime.h>
#include <hip/hip_cooperative_groups.h>
#include <cstdint>
#include <cstdio>
namespace cg = cooperative_groups;
#ifndef MK_MULTI
#define MK_MULTI 0
#endif
namespace pg8 {
#define PG8_LAS __attribute__((address_space(3)))
typedef unsigned short bf16_t;
typedef short bf16x8 __attribute__((ext_vector_type(8)));
typedef float f32x4 __attribute__((ext_vector_type(4)));
typedef unsigned u32x4 __attribute__((ext_vector_type(4)));
constexpr int BM = 256, BK = 64, HALF = 128, HTB = HALF * BK * 2  , STAGE_BYTES = 8 * HTB, NXCD = 8, WGM = 8;

__host__ __device__ __forceinline__ int lds_byte(int r, int c) { const int st = (r >> 4) * 2 + (c >> 5), rr = r & 15, cc = c & 31, ob = rr * 64 + cc * 2; return st * 1024 + (ob ^ (((ob >> 9) & 1) << 5)); }
__host__ __device__ __forceinline__ void stage_rc(int b, int& R, int& C) { const int st = b / 1024, sb = b % 1024, swz = sb ^ (((sb >> 9) & 1) << 5); R = (st >> 1) * 16 + swz / 64; C = (st & 1) * 32 + (swz % 64) / 2; }
__host__ __device__ __forceinline__ int perm32(int rho) { const int n = rho >> 4, i = rho & 15; return 8 * (i >> 2) + 4 * n + (i & 3); }

struct Unit { int pm, pn; };
struct Gemm { const bf16_t* A; const bf16_t* Bt; int M, N, K; };

struct StaticOrder {
    int nM, nN, nwg, G, c;
    __host__ __device__ void init(int M, int N, int G_, int c_) { nM = M / BM; nN = N / BM; nwg = nM * nN; G = G_; c = c_; }
    __host__ __device__ bool next(int i, Unit& u) const {
        const long L = (long)i * G + c; if (L >= nwg) return false;
        int wgid = (int)L; { const int q = nwg / NXCD, r = nwg % NXCD, xcd = wgid % NXCD, off = wgid / NXCD; wgid = (xcd < r ? xcd * (q + 1) : r * (q + 1) + (xcd - r) * q) + off; }
        const int nig = WGM * nN, gid = wgid / nig, fm = gid * WGM, gsz = (nM - fm) < WGM ? (nM - fm) : WGM;
        u.pm = fm + ((wgid % nig) % gsz); u.pn = (wgid % nig) / gsz; return true;
    }
    __device__ __forceinline__ void a_ready(const Unit&) const {}
    __device__ __forceinline__ void done(const Unit&) const {}
};

__device__ __forceinline__ unsigned cvt_pk_bf16(float lo, float hi) { unsigned r; asm volatile("v_cvt_pk_bf16_f32 %0, %1, %2" : "=v"(r) : "v"(lo), "v"(hi)); return r; }
typedef float f32x2 __attribute__((ext_vector_type(2)));
template <class Epi, class Sched, bool ALIGN_EPI = false, bool SP2 = false, bool ATILED = false>
__device__ __forceinline__ void gemm_phase(PG8_LAS unsigned char* lds, const Gemm g, const Sched& S, const Epi& E) {
    int tid_ = threadIdx.x; asm volatile("" : "+v"(tid_));
    const int tid = tid_, wid = __builtin_amdgcn_readfirstlane(tid >> 6), lane = tid & 63, wr = wid >> 2, wc = wid & 3, fr = lane & 15, fq = lane >> 4;
    const int K = g.K, nt = K / BK;
    unsigned voffA[2], voffB[2];
#pragma unroll
    for (int i = 0; i < 2; ++i) { int R, C; stage_rc(tid * 16 + i * 8192, R, C); const int Rb = Epi::PERM ? ((R & ~31) + perm32(R & 31)) : R;
        voffA[i] = ATILED ? (unsigned)(R * 64 + C) * 2u : (unsigned)(R * K + C) * 2u; voffB[i] = (unsigned)(Rb * K + C) * 2u; }
    const size_t kstep = (size_t)(BK * 2);
    const size_t hstep = (size_t)HALF * K * 2;
    const size_t tstep = 2 * hstep;
    const size_t kstepA = ATILED ? (size_t)32768 : kstep, hstepA = ATILED ? (size_t)16384 : hstep, tstepA = ATILED ? (size_t)(K / 64) * 32768 : tstep;
    const unsigned ldsw = (unsigned)wid * 1024u;
    const int aoff = lds_byte(wr * 64 + fr, fq * 8), boff = lds_byte(wc * 32 + fr, fq * 8);
#define PG8_SA(b, h) (((b) * 2 + (h)) * HTB)
#define PG8_SB(b, h) ((4 + (b) * 2 + (h)) * HTB)
#define PG8_STAGE(bufoff, gbase, voff) do { _Pragma("unroll") for (int _i = 0; _i < 2; ++_i) \
        __builtin_amdgcn_global_load_lds((const unsigned*)((const char*)(gbase) + (voff)[_i]), (PG8_LAS unsigned*)(lds + (bufoff) + ldsw + _i * 8192), 16, 0, 0); } while (0)
#define PG8_LDA(dst, b, h) do { _Pragma("unroll") for (int m = 0; m < 4; ++m) _Pragma("unroll") for (int k = 0; k < 2; ++k) dst[m][k] = *(const PG8_LAS bf16x8*)(lds + PG8_SA(b, h) + aoff + m * 2048 + k * 1024); } while (0)
#define PG8_LDB(dst, b, h) do { _Pragma("unroll") for (int n = 0; n < 2; ++n) _Pragma("unroll") for (int k = 0; k < 2; ++k) dst[n][k] = *(const PG8_LAS bf16x8*)(lds + PG8_SB(b, h) + boff + n * 2048 + k * 1024); } while (0)
#define PG8_MMA(ai, bj, At, Bt) do { __builtin_amdgcn_s_setprio(1); _Pragma("unroll") for (int m = 0; m < 4; ++m) _Pragma("unroll") for (int n = 0; n < 2; ++n) _Pragma("unroll") for (int k = 0; k < 2; ++k) \
        acc[ai][bj][m][n] = __builtin_amdgcn_mfma_f32_16x16x32_bf16(Bt[n][k], At[m][k], acc[ai][bj][m][n], 0, 0, 0); __builtin_amdgcn_s_setprio(0); } while (0)
#define PG8_WAIT_V(n) asm volatile("s_waitcnt vmcnt(" #n ")" ::: "memory")
#define PG8_WAIT_L(n) asm volatile("s_waitcnt lgkmcnt(" #n ")" ::: "memory")
#define PG8_BAR __builtin_amdgcn_s_barrier()
#define PG8_SCHED __builtin_amdgcn_sched_barrier(0)
    Unit cur, nxt; int ui = 0;
    if (!S.next(0, cur)) return;
    f32x4 acc[2][2][4][2];
#pragma unroll
    for (int a = 0; a < 2; ++a)
#pragma unroll
        for (int b = 0; b < 2; ++b)
#pragma unroll
            for (int m = 0; m < 4; ++m)
#pragma unroll
                for (int n = 0; n < 2; ++n) acc[a][b][m][n] = (f32x4){0.f, 0.f, 0.f, 0.f};
    bf16x8 At[4][2], B0[2][2], B1[2][2];
    const char* cA = (const char*)g.A + (size_t)cur.pm * tstepA; const char* cB = (const char*)g.Bt + (size_t)cur.pn * tstep;
    S.a_ready(cur);
    if constexpr (SP2) {
        PG8_STAGE(PG8_SB(0, 0), cB, voffB); PG8_STAGE(PG8_SB(0, 1), cB + hstep, voffB); PG8_STAGE(PG8_SA(0, 0), cA, voffA); PG8_STAGE(PG8_SA(0, 1), cA + hstepA, voffA);
        if (wr == 1) PG8_BAR;
        PG8_WAIT_V(2); PG8_BAR;
        PG8_STAGE(PG8_SB(1, 0), cB + kstep, voffB); PG8_STAGE(PG8_SA(1, 0), cA + kstepA, voffA); PG8_STAGE(PG8_SB(1, 1), cB + hstep + kstep, voffB);
        PG8_WAIT_V(6); PG8_BAR;
    } else {
        PG8_STAGE(PG8_SB(0, 0), cB, voffB); PG8_STAGE(PG8_SA(0, 0), cA, voffA); PG8_STAGE(PG8_SB(0, 1), cB + hstep, voffB); PG8_STAGE(PG8_SA(0, 1), cA + hstepA, voffA);
        if (wr == 1) PG8_BAR;
        PG8_WAIT_V(4); PG8_BAR;
        PG8_STAGE(PG8_SB(1, 0), cB + kstep, voffB); PG8_STAGE(PG8_SA(1, 0), cA + kstepA, voffA); PG8_STAGE(PG8_SB(1, 1), cB + hstep + kstep, voffB);
        PG8_WAIT_V(6); PG8_BAR;
    }
    for (;;) {
        const bool has_next = S.next(ui + 1, nxt);
        const char* nA = has_next ? (const char*)g.A + (size_t)nxt.pm * tstepA : cA; const char* nB = has_next ? (const char*)g.Bt + (size_t)nxt.pn * tstep : cB;
        for (int t = 0; t < nt; t += 2) {
            const bool last = (t == nt - 2);
            const char* a1 = cA + (size_t)(t + 1) * kstepA;
            const char* a2 = last ? nA : cA + (size_t)(t + 2) * kstepA; const char* b2 = last ? nB : cB + (size_t)(t + 2) * kstep;
            const char* a3 = a2 + kstepA; const char* b3 = b2 + kstep;
            if (last && has_next) S.a_ready(nxt);
            if constexpr (SP2) {
            PG8_LDB(B0, 0, 0); PG8_LDB(B1, 0, 1); PG8_SCHED; PG8_LDA(At, 0, 0); PG8_STAGE(PG8_SA(1, 1), a1 + hstepA, voffA);
            PG8_WAIT_V(8); PG8_WAIT_L(0); PG8_BAR; PG8_MMA(0, 0, At, B0); PG8_MMA(0, 1, At, B1); PG8_BAR; PG8_SCHED;
            PG8_LDA(At, 0, 1); PG8_STAGE(PG8_SB(0, 0), b2, voffB); PG8_STAGE(PG8_SB(0, 1), b2 + hstep, voffB); PG8_STAGE(PG8_SA(0, 0), a2, voffA);
            PG8_WAIT_V(8); PG8_WAIT_L(0); PG8_BAR; PG8_MMA(1, 0, At, B0); PG8_MMA(1, 1, At, B1); PG8_BAR; PG8_SCHED;
            PG8_LDB(B0, 1, 0); PG8_LDB(B1, 1, 1); PG8_SCHED; PG8_LDA(At, 1, 0); PG8_STAGE(PG8_SA(0, 1), a2 + hstepA, voffA);
            PG8_WAIT_V(8); PG8_WAIT_L(0); PG8_BAR; PG8_MMA(0, 0, At, B0); PG8_MMA(0, 1, At, B1); PG8_BAR; PG8_SCHED;
            PG8_LDA(At, 1, 1); PG8_STAGE(PG8_SB(1, 0), b3, voffB); PG8_STAGE(PG8_SB(1, 1), b3 + hstep, voffB); PG8_STAGE(PG8_SA(1, 0), a3, voffA);
            PG8_WAIT_V(8); PG8_WAIT_L(0); PG8_BAR; PG8_MMA(1, 0, At, B0); PG8_MMA(1, 1, At, B1); PG8_BAR; PG8_SCHED;
            } else {
            PG8_LDB(B0, 0, 0); PG8_SCHED; PG8_LDA(At, 0, 0); PG8_STAGE(PG8_SA(1, 1), a1 + hstepA, voffA);
            PG8_WAIT_L(8); PG8_BAR; PG8_WAIT_L(0); PG8_MMA(0, 0, At, B0); PG8_BAR; PG8_SCHED;
            PG8_LDB(B1, 0, 1); PG8_STAGE(PG8_SB(0, 0), b2, voffB);
            PG8_BAR; PG8_WAIT_L(0); PG8_MMA(0, 1, At, B1); PG8_BAR;
            PG8_LDA(At, 0, 1); PG8_STAGE(PG8_SA(0, 0), a2, voffA);
            PG8_BAR; PG8_WAIT_L(0); PG8_MMA(1, 0, At, B0); PG8_BAR; PG8_SCHED;
            PG8_STAGE(PG8_SB(0, 1), b2 + hstep, voffB);
            PG8_WAIT_V(6); PG8_BAR; PG8_MMA(1, 1, At, B1); PG8_BAR;
            PG8_LDB(B0, 1, 0); PG8_SCHED; PG8_LDA(At, 1, 0); PG8_STAGE(PG8_SA(0, 1), a2 + hstepA, voffA);
            PG8_WAIT_L(8); PG8_BAR; PG8_WAIT_L(0); PG8_MMA(0, 0, At, B0); PG8_BAR; PG8_SCHED;
            PG8_LDB(B1, 1, 1); PG8_STAGE(PG8_SB(1, 0), b3, voffB);
            PG8_BAR; PG8_WAIT_L(0); PG8_MMA(0, 1, At, B1); PG8_BAR;
            PG8_LDA(At, 1, 1); PG8_STAGE(PG8_SA(1, 0), a3, voffA);
            PG8_BAR; PG8_WAIT_L(0); PG8_MMA(1, 0, At, B0); PG8_BAR; PG8_SCHED;
            PG8_STAGE(PG8_SB(1, 1), b3 + hstep, voffB);
            PG8_WAIT_V(6); PG8_BAR; PG8_MMA(1, 1, At, B1); PG8_BAR;
            }
        }
        if constexpr (ALIGN_EPI) { if (wr == 0) PG8_BAR; }
        if constexpr (!Epi::AFTER_DRAIN) { E(acc, cur, wr, wc, fr, fq); S.done(cur); }
        if (!has_next) break;
#pragma unroll
        for (int a = 0; a < 2; ++a)
#pragma unroll
            for (int b = 0; b < 2; ++b)
#pragma unroll
                for (int m = 0; m < 4; ++m)
#pragma unroll
                    for (int n = 0; n < 2; ++n) acc[a][b][m][n] = (f32x4){0.f, 0.f, 0.f, 0.f};
        cur = nxt; cA = nA; cB = nB; ++ui;
        if constexpr (ALIGN_EPI) { if (wr == 1) PG8_BAR; }
    }
    PG8_WAIT_V(0);
    if constexpr (!ALIGN_EPI) { if (wr == 0) PG8_BAR; }
    PG8_BAR;
    if constexpr (Epi::AFTER_DRAIN) { E.fused(acc, cur, wr, wc, fr, fq, lds, wid, lane); S.done(cur); }
#undef PG8_SA
#undef PG8_SB
#undef PG8_STAGE
#undef PG8_LDA
#undef PG8_LDB
#undef PG8_MMA
#undef PG8_WAIT_V
#undef PG8_WAIT_L
#undef PG8_BAR
#undef PG8_SCHED
}
}
using pg8::bf16_t; using pg8::bf16x8; using pg8::f32x4;
typedef float f32x16 __attribute__((ext_vector_type(16)));
typedef unsigned u32x2 __attribute__((ext_vector_type(2)));
typedef unsigned u32x4 __attribute__((ext_vector_type(4)));
#define LAS __attribute__((address_space(3)))

constexpr int DM = 1024, SEQ = 16384, MP = 32768, MS = 128, DFF = 2816, NGLA = 3328;
constexpr float ALPHA = 1.4142135623730951f;
constexpr float LOG2E = 1.4426950408889634f;
constexpr float QSCALE = 0.125f * LOG2E;
constexpr float LN_EPS = 1e-5f, GN_EPS = 1e-6f;
constexpr int LDS_BYTES = 131072 + 256;

constexpr size_t MiB = 1u << 20;
constexpr size_t WS_WINA = 2 * MiB, WS_WOUTA = 8 * MiB, WS_WINB = 10 * MiB, WS_WOUTB = 17 * MiB, WS_WFI = 19 * MiB, WS_WFO = 41 * MiB;
constexpr size_t WS_X = 64 * MiB, ACT = 128 * MiB;
constexpr size_t WS_Q = ACT, WS_KB = ACT + 64 * MiB, WS_VT = ACT + 128 * MiB, WS_AO = ACT + 192 * MiB, WS_H = ACT;
constexpr size_t WS_QG = ACT, WS_KG = ACT + 32 * MiB, WS_VT1 = ACT + 64 * MiB, WS_RG = ACT + 128 * MiB, WS_GL = ACT + 192 * MiB, WS_KET = ACT + 194 * MiB,
                 WS_OG = ACT + 226 * MiB, WS_TG = ACT + 290 * MiB, WS_DEC = ACT + 322 * MiB, WS_PDG = ACT + 323 * MiB;
constexpr size_t SMP = 452 * MiB;
constexpr size_t WS_XS = SMP, WS_QS = SMP + 256 * 1024, WS_KSA = SMP + 1 * MiB, WS_VTSA = SMP + 10 * MiB, WS_HS = SMP + 19 * MiB, WS_QGS = SMP + 20 * MiB,
                 WS_KGS = SMP + 20 * MiB + 512 * 1024, WS_VTS = SMP + 21 * MiB, WS_RGS = SMP + 22 * MiB, WS_GLS = SMP + 22 * MiB + 256 * 1024,
                 WS_KETS = SMP + 22 * MiB + 512 * 1024, WS_DECS = SMP + 23 * MiB, WS_OGS = SMP + 23 * MiB + 256 * 1024, WS_AOS = SMP + 23 * MiB + 512 * 1024;
constexpr size_t O_YP = 0, O_YS = 33554432, O_AKP = 33685504, O_AVP = 34734080, O_SBP = 35782656, O_AKS = 36044800, O_AVS = 36175872, O_SBS = 36306944;

__device__ __forceinline__ unsigned pk2(float lo, float hi) { typedef float f2 __attribute__((ext_vector_type(2))); typedef __bf16 b2 __attribute__((ext_vector_type(2))); f2 v = {lo, hi}; b2 b = __builtin_convertvector(v, b2); return __builtin_bit_cast(unsigned, b); }
__device__ __forceinline__ bf16_t f2bf(float f) { return (bf16_t)(pk2(f, 0.f) & 0xffffu); }
__device__ __forceinline__ float bflo(unsigned u) { return __uint_as_float(u << 16); }
__device__ __forceinline__ float bfhi(unsigned u) { return __uint_as_float(u & 0xffff0000u); }
__device__ __forceinline__ float bf2f(bf16_t b) { return __uint_as_float((unsigned)b << 16); }
__device__ __forceinline__ float silu_f(float x) { return x * __builtin_amdgcn_rcpf(1.f + __builtin_amdgcn_exp2f(-x * LOG2E)); }
__device__ __forceinline__ float xhalf_max(float v) { auto rr = __builtin_amdgcn_permlane32_swap(__float_as_uint(v), __float_as_uint(v), false, false); return fmaxf(__uint_as_float(rr[0]), __uint_as_float(rr[1])); }
__device__ __forceinline__ float xhalf_sum(float v) { auto rr = __builtin_amdgcn_permlane32_swap(__float_as_uint(v), __float_as_uint(v), false, false); return __uint_as_float(rr[0]) + __uint_as_float(rr[1]); }
__device__ __forceinline__ float wave_sum(float v) {
#pragma unroll
    for (int o = 1; o < 64; o <<= 1) v += __shfl_xor(v, o);
    return v;
}
__device__ __forceinline__ bf16x8 pack8(const f32x16& p, int s8) {
    u32x4 w; w.x = pk2(p[s8 + 0], p[s8 + 1]); w.y = pk2(p[s8 + 2], p[s8 + 3]); w.z = pk2(p[s8 + 4], p[s8 + 5]); w.w = pk2(p[s8 + 6], p[s8 + 7]);
    return __builtin_bit_cast(bf16x8, w);
}
__device__ __forceinline__ int swap23(int v) { return (v & 0x13) | ((v & 4) << 1) | ((v & 8) >> 1); }
__device__ __forceinline__ size_t kf_addr(int bh, int nkt, int key, int d) { return ((((size_t)bh * nkt + (key >> 5)) * 4 + (d >> 4)) * 64 + ((d >> 3) & 1) * 32 + swap23(key & 31)) * 8 + (d & 7); }
__device__ __forceinline__ size_t vf_addr(int bh, int nkt, int key, int d) { return (((((size_t)bh * nkt + (key >> 5)) * 2 + (d >> 5)) * 2 + ((key >> 4) & 1)) * 64 + ((key >> 3) & 1) * 32 + (d & 31)) * 8 + (key & 7); }
#define MFMA32(a, b, c) __builtin_amdgcn_mfma_f32_32x32x16_bf16((a), (b), (c), 0, 0, 0)

struct EpiQKV {
    static constexpr bool PERM = true, AFTER_DRAIN = false;
    bf16_t *Q, *KB, *VT; float *akp, *avp;
    __device__ __forceinline__ void operator()(const f32x4 (&acc)[2][2][4][2], const pg8::Unit& u, int wr, int wc, int fr, int fq) const {
        const int sec = u.pn >> 2; const int cbase = (u.pn & 3) * 256 + wc * 32 + fq * 8;
        const int rbase = u.pm * 256 + wr * 64 + fr;
        if (sec == 0) {
            bf16_t* dst = Q + (size_t)rbase * 1024 + cbase;
#pragma unroll
            for (int ai = 0; ai < 2; ++ai)
#pragma unroll
                for (int m = 0; m < 4; ++m) {
#pragma unroll
                    for (int bj = 0; bj < 2; ++bj) { const f32x4 v0 = acc[ai][bj][m][0], v1 = acc[ai][bj][m][1];
                        u32x4 w; w.x = pk2(v0[0] * QSCALE, v0[1] * QSCALE); w.y = pk2(v0[2] * QSCALE, v0[3] * QSCALE); w.z = pk2(v1[0] * QSCALE, v1[1] * QSCALE); w.w = pk2(v1[2] * QSCALE, v1[3] * QSCALE);
                        *(u32x4*)(dst + (ai * 128 + m * 16) * 1024 + bj * 128) = w; }
                    asm volatile("" ::: "memory");
                }
        } else if (sec == 1) {
            const int b = rbase >> 14, tl0 = rbase & 16383;
#pragma unroll
            for (int bj = 0; bj < 2; ++bj) { const int c = cbase + bj * 128;
#pragma unroll
                for (int ai = 0; ai < 2; ++ai)
#pragma unroll
                    for (int m = 0; m < 4; ++m) { const f32x4 v0 = acc[ai][bj][m][0], v1 = acc[ai][bj][m][1];
                        u32x4 w; w.x = pk2(v0[0], v0[1]); w.y = pk2(v0[2], v0[3]); w.z = pk2(v1[0], v1[1]); w.w = pk2(v1[2], v1[3]);
                        *(u32x4*)(KB + kf_addr(b * 16 + (c >> 6), 512, tl0 + ai * 128 + m * 16, c & 63)) = w; }
                asm volatile("" ::: "memory"); }
        } else {
            const int b = rbase >> 14, tl0 = rbase & 16383;
#pragma unroll
            for (int bj = 0; bj < 2; ++bj) { const int c = cbase + bj * 128;
#pragma unroll
                for (int ai = 0; ai < 2; ++ai)
#pragma unroll
                    for (int m = 0; m < 4; ++m) { bf16_t* d2 = VT + vf_addr(b * 16 + (c >> 6), 512, tl0 + ai * 128 + m * 16, c & 63);
#pragma unroll
                        for (int n = 0; n < 2; ++n)
#pragma unroll
                            for (int e = 0; e < 4; ++e) d2[(4 * n + e) * 8] = f2bf(acc[ai][bj][m][n][e]); }
                asm volatile("" ::: "memory"); }
        }
        if (sec >= 1 && (rbase & 16383) >= 15872) {
            float* dst = (sec == 1 ? akp : avp) + (size_t)((rbase >> 14) * 512 + (rbase & 16383) - 15872) * 1024 + cbase;
#pragma unroll
            for (int ai = 0; ai < 2; ++ai)
#pragma unroll
                for (int m = 0; m < 4; ++m) {
#pragma unroll
                    for (int bj = 0; bj < 2; ++bj)
#pragma unroll
                        for (int n = 0; n < 2; ++n) *(f32x4*)(dst + (ai * 128 + m * 16) * 1024 + bj * 128 + n * 4) = acc[ai][bj][m][n];
                    asm volatile("" ::: "memory");
                }
        }
    }
};
template <int MODE>
struct EpiVT {
    static constexpr bool PERM = true, AFTER_DRAIN = false;
    bf16_t* VT; float* avp;
    __device__ __forceinline__ void operator()(const f32x4 (&acc)[2][2][4][2], const pg8::Unit& u, int wr, int wc, int fr, int fq) const {
        const int fbase = u.pm * 256 + wr * 64 + fr;
        const int tbase = u.pn * 256 + wc * 32 + fq * 8;
#pragma unroll
        for (int ai = 0; ai < 2; ++ai)
#pragma unroll
            for (int m = 0; m < 4; ++m) {
                const int f = fbase + ai * 128 + m * 16;
#pragma unroll
                for (int bj = 0; bj < 2; ++bj) {
                    const int tok = tbase + bj * 128; const int b = tok >> 14, tl = tok & 16383; const f32x4 v0 = acc[ai][bj][m][0], v1 = acc[ai][bj][m][1];
                    u32x4 w; w.x = pk2(v0[0], v0[1]); w.y = pk2(v0[2], v0[3]); w.z = pk2(v1[0], v1[1]); w.w = pk2(v1[2], v1[3]);
                    if (MODE == 0) {
                        *(u32x4*)(VT + vf_addr(b * 16 + (f >> 6), 512, tl, f & 63)) = w;
                        if (tl >= 15872) { float* d = avp + (size_t)(b * 512 + tl - 15872) * 1024 + f;
                            d[0] = v0[0]; d[1024] = v0[1]; d[2048] = v0[2]; d[3072] = v0[3]; d[4096] = v1[0]; d[5120] = v1[1]; d[6144] = v1[2]; d[7168] = v1[3]; }
                    } else {
                        *(u32x4*)(VT + (size_t)(b * 1024 + f) * 16384 + tl) = w;
                    }
                }
                asm volatile("" ::: "memory");
            }
    }
};
struct EpiGlaR {
    static constexpr bool PERM = true, AFTER_DRAIN = false;
    bf16_t* RG; float* GL;
    __device__ __forceinline__ void operator()(const f32x4 (&acc)[2][2][4][2], const pg8::Unit& u, int wr, int wc, int fr, int fq) const {
        const int pn = u.pn; const int cb = wc * 32 + fq * 8; const int rbase = u.pm * 256 + wr * 64 + fr;
        if (pn < 4) {
            bf16_t* dst = RG + (size_t)rbase * 1024 + pn * 256 + cb;
#pragma unroll
            for (int ai = 0; ai < 2; ++ai)
#pragma unroll
                for (int m = 0; m < 4; ++m) {
#pragma unroll
                    for (int bj = 0; bj < 2; ++bj) { const f32x4 v0 = acc[ai][bj][m][0], v1 = acc[ai][bj][m][1];
                        u32x4 w; w.x = pk2(v0[0], v0[1]); w.y = pk2(v0[2], v0[3]); w.z = pk2(v1[0], v1[1]); w.w = pk2(v1[2], v1[3]);
                        *(u32x4*)(dst + (size_t)(ai * 128 + m * 16) * 1024 + bj * 128) = w; }
                    asm volatile("" ::: "memory");
                }
        } else if (cb < 16) {
#pragma unroll
            for (int ai = 0; ai < 2; ++ai)
#pragma unroll
                for (int m = 0; m < 4; ++m) { float* gp = GL + (size_t)(rbase + ai * 128 + m * 16) * 16 + cb; *(f32x4*)gp = acc[ai][0][m][0]; *(f32x4*)(gp + 4) = acc[ai][0][m][1]; }
        }
    }
};
template <bool XT>
struct EpiResT {
    static constexpr bool PERM = true, AFTER_DRAIN = false;
    const bf16_t* X; bf16_t* PRE;
    __device__ __forceinline__ void operator()(const f32x4 (&acc)[2][2][4][2], const pg8::Unit& u, int wr, int wc, int fr, int fq) const {
        const size_t base = (size_t)(u.pm * 256 + wr * 64 + fr) * 1024 + u.pn * 256 + wc * 32 + fq * 8;
        const int r0_ = u.pm * 256 + wr * 64 + fr, c0_ = u.pn * 256 + wc * 32 + fq * 8;
        const bf16_t* xp = XT ? X + (((size_t)u.pm * 16 + (c0_ >> 6)) * 256 + (r0_ & 255)) * 64 + (c0_ & 63) : X + base; bf16_t* pp = PRE + base;
#pragma unroll
        for (int ai = 0; ai < 2; ++ai)
#pragma unroll
            for (int m = 0; m < 4; ++m) {
                u32x4 xx[2];
#pragma unroll
                for (int bj = 0; bj < 2; ++bj) xx[bj] = XT ? *(const u32x4*)(xp + (ai * 128 + m * 16) * 64 + bj * 2 * 16384) : *(const u32x4*)(xp + (ai * 128 + m * 16) * 1024 + bj * 128);
#pragma unroll
                for (int bj = 0; bj < 2; ++bj) {
                    const f32x4 v0 = acc[ai][bj][m][0], v1 = acc[ai][bj][m][1]; const u32x4 x4 = xx[bj];
                    u32x4 w; w.x = pk2(ALPHA * bflo(x4.x) + v0[0], ALPHA * bfhi(x4.x) + v0[1]); w.y = pk2(ALPHA * bflo(x4.y) + v0[2], ALPHA * bfhi(x4.y) + v0[3]);
                    w.z = pk2(ALPHA * bflo(x4.z) + v1[0], ALPHA * bfhi(x4.z) + v1[1]); w.w = pk2(ALPHA * bflo(x4.w) + v1[2], ALPHA * bfhi(x4.w) + v1[3]);
                    *(u32x4*)(pp + (ai * 128 + m * 16) * 1024 + bj * 128) = w;
                }
                asm volatile("" ::: "memory");
            }
    }
};
typedef EpiResT<false> EpiRes;
struct EpiSwi {
    static constexpr bool PERM = true, AFTER_DRAIN = false;
    bf16_t* H;
    __device__ __forceinline__ void operator()(const f32x4 (&acc)[2][2][4][2], const pg8::Unit& u, int wr, int wc, int fr, int fq) const {
        const int hc = u.pn * 128 + wc * 32 + fq * 8;
#pragma unroll
        for (int ai = 0; ai < 2; ++ai)
#pragma unroll
            for (int m = 0; m < 4; ++m) {
                const int row = u.pm * 256 + ai * 128 + wr * 64 + m * 16 + fr;
                const f32x4 g0 = acc[ai][0][m][0], g1 = acc[ai][0][m][1], u0 = acc[ai][1][m][0], u1 = acc[ai][1][m][1];
                u32x4 w; w.x = pk2(silu_f(g0[0]) * u0[0], silu_f(g0[1]) * u0[1]); w.y = pk2(silu_f(g0[2]) * u0[2], silu_f(g0[3]) * u0[3]);
                w.z = pk2(silu_f(g1[0]) * u1[0], silu_f(g1[1]) * u1[1]); w.w = pk2(silu_f(g1[2]) * u1[2], silu_f(g1[3]) * u1[3]);
                *(u32x4*)(H + ((((size_t)(row >> 8) * (DFF / 64) + (hc >> 6)) * 256 + (row & 255)) * 64 + (hc & 63))) = w;
            }
    }
};
struct EpiGla {
    static constexpr bool PERM = true, AFTER_DRAIN = false;
    bf16_t *QG, *KG, *VT, *RG; float* GL;
    __device__ __forceinline__ void operator()(const f32x4 (&acc)[2][2][4][2], const pg8::Unit& u, int wr, int wc, int fr, int fq) const {
        const int pn = u.pn; const int cb = wc * 32 + fq * 8; const int rbase = u.pm * 256 + wr * 64 + fr;
        if (pn < 4 || (pn >= 8 && pn < 12)) {
            bf16_t* dst; int ld;
            if (pn < 2) { dst = QG + (size_t)rbase * 512 + pn * 256 + cb; ld = 512; }
            else if (pn < 4) { dst = KG + (size_t)rbase * 512 + (pn - 2) * 256 + cb; ld = 512; }
            else { dst = RG + (size_t)rbase * 1024 + (pn - 8) * 256 + cb; ld = 1024; }
#pragma unroll
            for (int ai = 0; ai < 2; ++ai)
#pragma unroll
                for (int m = 0; m < 4; ++m) {
#pragma unroll
                    for (int bj = 0; bj < 2; ++bj) { const f32x4 v0 = acc[ai][bj][m][0], v1 = acc[ai][bj][m][1];
                        u32x4 w; w.x = pk2(v0[0], v0[1]); w.y = pk2(v0[2], v0[3]); w.z = pk2(v1[0], v1[1]); w.w = pk2(v1[2], v1[3]);
                        *(u32x4*)(dst + (size_t)(ai * 128 + m * 16) * ld + bj * 128) = w; }
                    asm volatile("" ::: "memory");
                }
        } else if (pn < 8) {
            const int b = rbase >> 14, tl0 = rbase & 16383;
            bf16_t* dst = VT + (size_t)(b * 1024 + (pn - 4) * 256 + cb) * 16384 + tl0;
#pragma unroll
            for (int bj = 0; bj < 2; ++bj)
#pragma unroll
                for (int n = 0; n < 2; ++n) {
#pragma unroll
                    for (int e = 0; e < 4; ++e) { bf16_t* d2 = dst + (size_t)(bj * 128 + n * 4 + e) * 16384;
#pragma unroll
                        for (int ai = 0; ai < 2; ++ai)
#pragma unroll
                            for (int m = 0; m < 4; ++m) d2[ai * 128 + m * 16] = f2bf(acc[ai][bj][m][n][e]);
                        asm volatile("" ::: "memory"); }
                }
        } else {
            if (cb < 16) {
#pragma unroll
                for (int ai = 0; ai < 2; ++ai)
#pragma unroll
                    for (int m = 0; m < 4; ++m) { float* gp = GL + (size_t)(rbase + ai * 128 + m * 16) * 16 + cb; *(f32x4*)gp = acc[ai][0][m][0]; *(f32x4*)(gp + 4) = acc[ai][0][m][1]; }
            }
        }
    }
};

template <bool DUAL, class F>
__device__ __forceinline__ void small_gemm(const bf16_t* A, const bf16_t* Bt, int K, int nct, LAS float* red, int wave, int lane_, const F& epi) {
    int lane = lane_; asm volatile("" : "+v"(lane));
    const int x = lane & 31, kq = lane >> 5; const int kw = K >> 3;
    constexpr int NC = DUAL ? 32 : 16;
    for (int it = blockIdx.x; it < 4 * nct; it += gridDim.x) {
        const int rt = it & 3, ct = it >> 2;
        int nb0, nb1; if (DUAL) { nb0 = (ct >> 2) * 256 + (ct & 3) * 32; nb1 = nb0 + 128; } else { nb0 = ct * 32; nb1 = nb0; }
        const bf16_t* pa = A + (size_t)(rt * 32 + x) * K + wave * kw + kq * 8;
        const bf16_t* pb0 = Bt + (size_t)(nb0 + x) * K + wave * kw + kq * 8;
        const bf16_t* pb1 = Bt + (size_t)(nb1 + x) * K + wave * kw + kq * 8;
        f32x16 c0 = f32x16{}, c1 = f32x16{};
#pragma unroll 8
        for (int k = 0; k < kw; k += 16) {
            const bf16x8 a = *(const bf16x8*)(pa + k), b0 = *(const bf16x8*)(pb0 + k);
            c0 = MFMA32(a, b0, c0);
            if (DUAL) { const bf16x8 b1 = *(const bf16x8*)(pb1 + k); c1 = MFMA32(a, b1, c1); }
        }
        LAS float* mine = red + (wave * 64 + lane) * (NC + 1);
#pragma unroll
        for (int r = 0; r < 16; ++r) { mine[r] = c0[r]; if (DUAL) mine[16 + r] = c1[r]; }
        __syncthreads();
#pragma unroll
        for (int rr = 0; rr < 2; ++rr) {
            const int r = 2 * wave + rr; float s0 = 0.f, s1 = 0.f;
#pragma unroll
            for (int ww = 0; ww < 8; ++ww) { const LAS float* p = red + (ww * 64 + lane) * (NC + 1); s0 += p[r]; if (DUAL) s1 += p[16 + r]; }
            const int row = rt * 32 + (r & 3) + 8 * (r >> 2) + 4 * kq;
            epi(row, ct * 32 + x, s0, s1);
        }
        __syncthreads();
    }
}
struct SQkv { bf16_t *QS, *KSA, *VTSA; float *aks, *avs;
    __device__ __forceinline__ void operator()(int row, int col, float v, float) const {
        const int bs = row >> 4, t = row & 15;
        if (col < 1024) QS[row * 1024 + col] = f2bf(v * QSCALE);
        else if (col < 2048) { const int c = col - 1024; KSA[kf_addr(bs * 16 + (c >> 6), 18, 512 + t, c & 63)] = f2bf(v); aks[row * 1024 + c] = v; }
        else { const int c = col - 2048; VTSA[vf_addr(bs * 16 + (c >> 6), 18, 512 + t, c & 63)] = f2bf(v); avs[row * 1024 + c] = v; }
    } };
struct SRes { const bf16_t* XS; float* PRE;
    __device__ __forceinline__ void operator()(int row, int col, float v, float) const { PRE[row * 1024 + col] = ALPHA * bf2f(XS[row * 1024 + col]) + v; } };
struct SSwi { bf16_t* HS;
    __device__ __forceinline__ void operator()(int row, int col, float g, float u) const { HS[row * DFF + col] = f2bf(silu_f(g) * u); } };
struct SGla { bf16_t *QGS, *KGS, *VTS, *RGS; float* GLS;
    __device__ __forceinline__ void operator()(int row, int col, float v, float) const {
        const int bs = row >> 4, t = row & 15, prow = bs * 64 + t;
        if (col < 512) QGS[prow * 512 + col] = f2bf(v);
        else if (col < 1024) KGS[prow * 512 + col - 512] = f2bf(v);
        else if (col < 2048) VTS[(size_t)(bs * 1024 + col - 1024) * 64 + t] = f2bf(v);
        else if (col < 3072) RGS[row * 1024 + col - 2048] = f2bf(v);
        else if (col < 3088) GLS[prow * 16 + col - 3072] = v;
    } };

template <int R>
__device__ __forceinline__ void ln_rows_t(const float* pre, int row, const float* g, const float* bta, bf16_t* xo, float* fo, int lane) {
    f32x4 v[R][4];
#pragma unroll
    for (int r = 0; r < R; ++r) { const f32x4* pr = (const f32x4*)(pre + (size_t)(row + r) * 1024) + lane;
#pragma unroll
        for (int j = 0; j < 4; ++j) v[r][j] = pr[64 * j]; }
    f32x4 gg[4], bb[4];
#pragma unroll
    for (int j = 0; j < 4; ++j) { gg[j] = ((const f32x4*)g)[lane + 64 * j]; bb[j] = ((const f32x4*)bta)[lane + 64 * j]; }
#pragma unroll
    for (int r = 0; r < R; ++r) {
        float s = 0.f;
#pragma unroll
        for (int j = 0; j < 4; ++j) s += (v[r][j][0] + v[r][j][1]) + (v[r][j][2] + v[r][j][3]);
        const float mean = wave_sum(s) * (1.f / 1024.f); float s2 = 0.f;
#pragma unroll
        for (int j = 0; j < 4; ++j) { v[r][j] = v[r][j] - mean; s2 += (v[r][j][0] * v[r][j][0] + v[r][j][1] * v[r][j][1]) + (v[r][j][2] * v[r][j][2] + v[r][j][3] * v[r][j][3]); }
        const float rstd = 1.f / sqrtf(wave_sum(s2) * (1.f / 1024.f) + LN_EPS);
#pragma unroll
        for (int j = 0; j < 4; ++j) {
            const f32x4 y = v[r][j] * rstd * gg[j] + bb[j];
            if (xo) { u32x2 w; w.x = pk2(y[0], y[1]); w.y = pk2(y[2], y[3]); *((u32x2*)(xo + (size_t)(row + r) * 1024) + lane + 64 * j) = w; }
            if (fo) *((f32x4*)(fo + (size_t)(row + r) * 1024) + lane + 64 * j) = y;
        }
    }
}
__device__ __forceinline__ void ln_rows(const float* pre, int nrows, const float* g, const float* bta, bf16_t* xo, float* fo, int gw, int ngw, int lane_) {
    int lane = lane_; asm volatile("" : "+v"(lane));
    for (int row = gw; row < nrows; row += ngw) ln_rows_t<1>(pre, row, g, bta, xo, fo, lane);
}
template <int R, bool XT = false>
__device__ __forceinline__ void lnb_rows(const bf16_t* pre, int nrows, const float* g, const float* bta, bf16_t* xo, float* fo, int gw, int ngw, int lane_) {
    int lane = lane_; asm volatile("" : "+v"(lane));
    f32x4 gg[4], bb[4];
#pragma unroll
    for (int j = 0; j < 2; ++j) { gg[2 * j] = *(const f32x4*)(g + 512 * j + 8 * lane); gg[2 * j + 1] = *(const f32x4*)(g + 512 * j + 8 * lane + 4);
                                  bb[2 * j] = *(const f32x4*)(bta + 512 * j + 8 * lane); bb[2 * j + 1] = *(const f32x4*)(bta + 512 * j + 8 * lane + 4); }
    for (int row = R * gw; row < nrows; row += R * ngw) {
        u32x4 raw[R][2];
#pragma unroll
        for (int r = 0; r < R; ++r)
#pragma unroll
            for (int j = 0; j < 2; ++j) raw[r][j] = *(const u32x4*)(pre + (size_t)(row + r) * 1024 + 512 * j + 8 * lane);
#pragma unroll
        for (int r = 0; r < R; ++r) {
            f32x4 v[4];
#pragma unroll
            for (int j = 0; j < 2; ++j) { const u32x4 w = raw[r][j]; v[2 * j] = f32x4{bflo(w.x), bfhi(w.x), bflo(w.y), bfhi(w.y)}; v[2 * j + 1] = f32x4{bflo(w.z), bfhi(w.z), bflo(w.w), bfhi(w.w)}; }
            float s = 0.f;
#pragma unroll
            for (int j = 0; j < 4; ++j) s += (v[j][0] + v[j][1]) + (v[j][2] + v[j][3]);
            const float mean = wave_sum(s) * (1.f / 1024.f); float s2 = 0.f;
#pragma unroll
            for (int j = 0; j < 4; ++j) { v[j] = v[j] - mean; s2 += (v[j][0] * v[j][0] + v[j][1] * v[j][1]) + (v[j][2] * v[j][2] + v[j][3] * v[j][3]); }
            const float rstd = 1.f / sqrtf(wave_sum(s2) * (1.f / 1024.f) + LN_EPS);
#pragma unroll
            for (int j = 0; j < 2; ++j) {
                const f32x4 y0 = v[2 * j] * rstd * gg[2 * j] + bb[2 * j], y1 = v[2 * j + 1] * rstd * gg[2 * j + 1] + bb[2 * j + 1];
                if (xo) { u32x4 w; w.x = pk2(y0[0], y0[1]); w.y = pk2(y0[2], y0[3]); w.z = pk2(y1[0], y1[1]); w.w = pk2(y1[2], y1[3]); if (XT) { const int rr_ = row + r, cc_ = 512 * j + 8 * lane; *(u32x4*)(xo + ((((size_t)(rr_ >> 8) * 16 + (cc_ >> 6)) * 256 + (rr_ & 255)) * 64 + (cc_ & 63))) = w; }
                    else *(u32x4*)(xo + (size_t)(row + r) * 1024 + 512 * j + 8 * lane) = w; }
                if (fo) { *(f32x4*)(fo + (size_t)(row + r) * 1024 + 512 * j + 8 * lane) = y0; *(f32x4*)(fo + (size_t)(row + r) * 1024 + 512 * j + 8 * lane + 4) = y1; }
            }
        }
    }
}

#define LDS_WAIT() asm volatile("s_waitcnt lgkmcnt(0)" ::: "memory")
__device__ __forceinline__ void tr_item(const float* W, int K, int N, bf16_t* WT, int mode, LAS float* scr, int item, int lane_) {
    int lane = lane_; asm volatile("" : "+v"(lane));
    const int nblk = (N + 31) >> 5, kb = item / nblk, nb = item - kb * nblk, k0 = 64 * kb, n0 = 32 * nb;
    const int nn = n0 + (lane & 31); const bool ok = nn < N;
    float tv[32];
#pragma unroll
    for (int i = 0; i < 32; ++i) { const int kk = 2 * i + (lane >> 5); tv[i] = ok ? W[(size_t)(k0 + kk) * N + nn] : 0.f; }
#pragma unroll
    for (int i = 0; i < 32; ++i) { const int kk = 2 * i + (lane >> 5); scr[kk * 33 + (lane & 31)] = tv[i]; }
    LDS_WAIT();
    int r0 = n0;
    if (mode == 1) r0 = (n0 < DFF) ? ((n0 >> 7) * 256 + (n0 & 127)) : (((n0 - DFF) >> 7) * 256 + 128 + ((n0 - DFF) & 127));
    const int c = lane & 7;
#pragma unroll
    for (int j = 0; j < 4; ++j) { const int n = (lane >> 3) + 8 * j; const LAS float* s = scr + (8 * c) * 33 + n;
        u32x4 o; o.x = pk2(s[0 * 33], s[1 * 33]); o.y = pk2(s[2 * 33], s[3 * 33]); o.z = pk2(s[4 * 33], s[5 * 33]); o.w = pk2(s[6 * 33], s[7 * 33]);
        *(u32x4*)(WT + (size_t)(r0 + n) * K + k0 + 8 * c) = o; }
    LDS_WAIT();
}

template <int NQT>
__device__ __forceinline__ void attn_unit_safe(const bf16_t* Qp, int qvalid, const bf16_t* Kp, const bf16_t* Vtp, int kt_lo, int kt_hi, int nkeys,
                                          const LAS float* bias, float bconst, bf16_t* Op, int lane_) {
    int lane = lane_; asm volatile("" : "+v"(lane));
    const int x = lane & 31, hi = lane >> 5; const int sx = (x & 0x13) | ((x & 4) << 1) | ((x & 8) >> 1);
    bf16x8 qf[NQT][4];
#pragma unroll
    for (int qt = 0; qt < NQT; ++qt) { int qr = qt * 32 + x; if (qr >= qvalid) qr = qvalid - 1;
#pragma unroll
        for (int d0 = 0; d0 < 4; ++d0) qf[qt][d0] = *(const bf16x8*)(Qp + (size_t)qr * 1024 + d0 * 16 + hi * 8); }
    float mrow[NQT], lrow[NQT]; f32x16 o[NQT][2];
#pragma unroll
    for (int qt = 0; qt < NQT; ++qt) { mrow[qt] = -1e30f; lrow[qt] = 0.f; o[qt][0] = f32x16{}; o[qt][1] = f32x16{}; }
    bf16x8 kf[4], vf[2][2];
#define ATT_LOAD(KF, VF, kk) do { const bf16_t* kp_ = Kp + (long)(kk) * 2048 + lane * 8; const bf16_t* vp_ = Vtp + (long)(kk) * 2048 + lane * 8; \
        _Pragma("unroll") for (int d0 = 0; d0 < 4; ++d0) KF[d0] = *(const bf16x8*)(kp_ + d0 * 512); \
        _Pragma("unroll") for (int dt = 0; dt < 2; ++dt) _Pragma("unroll") for (int s_ = 0; s_ < 2; ++s_) VF[dt][s_] = *(const bf16x8*)(vp_ + (dt * 2 + s_) * 512); } while (0)
    ATT_LOAD(kf, vf, kt_lo);
    for (int kt = kt_lo; kt < kt_hi; ++kt) {
        bf16x8 kn[4], vn[2][2];
        { const int kk = (kt + 1 < kt_hi) ? kt + 1 : kt; ATT_LOAD(kn, vn, kk); }
        const bool need_mask = (kt + 1) * 32 > nkeys;
#pragma unroll
        for (int qt = 0; qt < NQT; ++qt) {
            f32x16 s;
            { const float c0 = bconst;
#pragma unroll
              for (int r = 0; r < 16; ++r) s[r] = c0; }
#pragma unroll
            for (int d0 = 0; d0 < 4; ++d0) s = MFMA32(kf[d0], qf[qt][d0], s);
            const int i = qt * 32 + x;
            if (kt >= 12) {
#pragma unroll
                for (int r = 0; r < 16; ++r) { const int j = kt * 32 + 16 * (r >> 3) + 8 * hi + (r & 7); s[r] += bias[i - j + 640]; }
            }
            if (need_mask) {
#pragma unroll
                for (int r = 0; r < 16; ++r) { const int j = kt * 32 + 16 * (r >> 3) + 8 * hi + (r & 7); if (j >= nkeys) s[r] = -1e30f; }
            }
            float mx = s[0];
#pragma unroll
            for (int r = 1; r < 16; ++r) mx = fmaxf(mx, s[r]);
            mx = xhalf_max(mx);
            const float mnew = fmaxf(mrow[qt], mx); const float alpha = __builtin_amdgcn_exp2f(mrow[qt] - mnew);
            float rs = 0.f;
#pragma unroll
            for (int r = 0; r < 16; ++r) { s[r] = __builtin_amdgcn_exp2f(s[r] - mnew); rs += s[r]; }
            rs = xhalf_sum(rs);
            lrow[qt] = lrow[qt] * alpha + rs; mrow[qt] = mnew;
            if (__any(alpha != 1.f)) {
#pragma unroll
                for (int r = 0; r < 16; ++r) { o[qt][0][r] *= alpha; o[qt][1][r] *= alpha; }
            }
            const bf16x8 p0 = pack8(s, 0), p1 = pack8(s, 8);
#pragma unroll
            for (int dt = 0; dt < 2; ++dt) { o[qt][dt] = MFMA32(vf[dt][0], p0, o[qt][dt]); o[qt][dt] = MFMA32(vf[dt][1], p1, o[qt][dt]); }
        }
#pragma unroll
        for (int d0 = 0; d0 < 4; ++d0) kf[d0] = kn[d0];
#pragma unroll
        for (int dt = 0; dt < 2; ++dt) { vf[dt][0] = vn[dt][0]; vf[dt][1] = vn[dt][1]; }
    }
#undef ATT_LOAD
#pragma unroll
    for (int qt = 0; qt < NQT; ++qt) {
        const float inv = 1.f / lrow[qt]; const int q = qt * 32 + x;
        if (q < qvalid) {
#pragma unroll
            for (int dt = 0; dt < 2; ++dt)
#pragma unroll
                for (int r4 = 0; r4 < 4; ++r4) {
                    u32x2 w; w.x = pk2(o[qt][dt][4 * r4 + 0] * inv, o[qt][dt][4 * r4 + 1] * inv); w.y = pk2(o[qt][dt][4 * r4 + 2] * inv, o[qt][dt][4 * r4 + 3] * inv);
                    *(u32x2*)(Op + (size_t)q * 1024 + dt * 32 + 8 * r4 + 4 * hi) = w;
                }
        }
    }
}

template <int NQT>
__device__ __forceinline__ bool attn_unit_fast(const bf16_t* Qp, int qvalid, const bf16_t* Kp, const bf16_t* Vtp, int kt_lo, int kt_hi, int nkeys,
                                               const LAS float* bias, float bconst, bf16_t* Op, int lane_) {
    int lane = lane_; asm volatile("" : "+v"(lane));
    const int x = lane & 31, hi = lane >> 5;
    bf16x8 qf[NQT][4];
#pragma unroll
    for (int qt = 0; qt < NQT; ++qt) { int qr = qt * 32 + x; if (qr >= qvalid) qr = qvalid - 1;
#pragma unroll
        for (int d0 = 0; d0 < 4; ++d0) qf[qt][d0] = *(const bf16x8*)(Qp + (size_t)qr * 1024 + d0 * 16 + hi * 8); }
    bf16x8 kf[4];
#define ATT_LOADK(KF, kk) do { const bf16_t* kp_ = Kp + (long)(kk) * 2048 + lane * 8; \
        _Pragma("unroll") for (int d0 = 0; d0 < 4; ++d0) KF[d0] = *(const bf16x8*)(kp_ + d0 * 512); } while (0)
#define ATT_LOADV(VF, kk) do { const bf16_t* vp_ = Vtp + (long)(kk) * 2048 + lane * 8; \
        _Pragma("unroll") for (int dt = 0; dt < 2; ++dt) _Pragma("unroll") for (int s_ = 0; s_ < 2; ++s_) VF[dt][s_] = *(const bf16x8*)(vp_ + (dt * 2 + s_) * 512); } while (0)
    ATT_LOADK(kf, kt_lo);
    f32x16 negm; float lsum[NQT]; f32x16 o[NQT][2];
    {
        float mxs = -1e30f;
#pragma unroll
        for (int qt = 0; qt < NQT; ++qt) {
            f32x16 s = f32x16{};
#pragma unroll
            for (int d0 = 0; d0 < 4; ++d0) s = MFMA32(kf[d0], qf[qt][d0], s);
            const int i = qt * 32 + x;
            if (kt_lo >= 12) {
#pragma unroll
                for (int r = 0; r < 16; ++r) { const int j = kt_lo * 32 + 16 * (r >> 3) + 8 * hi + (r & 7); s[r] += bias[i - j + 640]; }
            }
            float mx = s[0];
#pragma unroll
            for (int r = 1; r < 16; ++r) mx = fmaxf(mx, s[r]);
            mxs = fmaxf(mxs, xhalf_max(mx));
            lsum[qt] = 0.f; o[qt][0] = f32x16{}; o[qt][1] = f32x16{};
        }
#pragma unroll
        for (int r = 0; r < 16; ++r) negm[r] = -mxs;
        asm volatile("" : "+v"(negm));
    }
    for (int kt = kt_lo; kt < kt_hi; ++kt) {
        bf16x8 kn[4], vf[2][2];
        ATT_LOADV(vf, kt);
        { const int kk = (kt + 1 < kt_hi) ? kt + 1 : kt; ATT_LOADK(kn, kk); }
        const bool need_mask = (kt + 1) * 32 > nkeys;
        f32x16 sa[NQT], sb[NQT];
        __builtin_amdgcn_s_setprio(1);
#pragma unroll
        for (int qt = 0; qt < NQT; ++qt) { sa[qt] = MFMA32(kf[0], qf[qt][0], negm); sb[qt] = MFMA32(kf[1], qf[qt][1], f32x16{}); }
#pragma unroll
        for (int qt = 0; qt < NQT; ++qt) { sa[qt] = MFMA32(kf[2], qf[qt][2], sa[qt]); sb[qt] = MFMA32(kf[3], qf[qt][3], sb[qt]); }
        __builtin_amdgcn_s_setprio(0);
#pragma unroll
        for (int qt = 0; qt < NQT; ++qt) {
            f32x16 s = sa[qt] + sb[qt];
            const int i = qt * 32 + x;
            if (kt >= 12) {
#pragma unroll
                for (int r = 0; r < 16; ++r) { const int j = kt * 32 + 16 * (r >> 3) + 8 * hi + (r & 7); s[r] += bias[i - j + 640]; }
            }
            if (need_mask) {
#pragma unroll
                for (int r = 0; r < 16; ++r) { const int j = kt * 32 + 16 * (r >> 3) + 8 * hi + (r & 7); if (j >= nkeys) s[r] = -1e30f; }
            }
#pragma unroll
            for (int r = 0; r < 16; ++r) s[r] = __builtin_amdgcn_exp2f(s[r]);
            lsum[qt] += ((s[0] + s[1]) + (s[2] + s[3])) + ((s[4] + s[5]) + (s[6] + s[7])) + (((s[8] + s[9]) + (s[10] + s[11])) + ((s[12] + s[13]) + (s[14] + s[15])));
            const bf16x8 p0 = pack8(s, 0), p1 = pack8(s, 8);
#pragma unroll
            for (int dt = 0; dt < 2; ++dt) { o[qt][dt] = MFMA32(vf[dt][0], p0, o[qt][dt]); o[qt][dt] = MFMA32(vf[dt][1], p1, o[qt][dt]); }
        }
#pragma unroll
        for (int d0 = 0; d0 < 4; ++d0) kf[d0] = kn[d0];
    }
#undef ATT_LOADK
#undef ATT_LOADV
    bool bad = false; float inv[NQT];
#pragma unroll
    for (int qt = 0; qt < NQT; ++qt) { const float l = xhalf_sum(lsum[qt]); bad = bad || !(l > 1e-30f && l < 1e30f); inv[qt] = 1.f / l; }
    if (__any(bad)) return false;
#pragma unroll
    for (int qt = 0; qt < NQT; ++qt) {
        const int q = qt * 32 + x;
        if (q < qvalid) {
#pragma unroll
            for (int dt = 0; dt < 2; ++dt)
#pragma unroll
                for (int r4 = 0; r4 < 4; ++r4) {
                    u32x2 w; w.x = pk2(o[qt][dt][4 * r4 + 0] * inv[qt], o[qt][dt][4 * r4 + 1] * inv[qt]); w.y = pk2(o[qt][dt][4 * r4 + 2] * inv[qt], o[qt][dt][4 * r4 + 3] * inv[qt]);
                    *(u32x2*)(Op + (size_t)q * 1024 + dt * 32 + 8 * r4 + 4 * hi) = w;
                }
        }
    }
    return true;
}
__device__ __forceinline__ void gate_unit(bf16_t* Qg, bf16_t* Kg, const float* GL, bf16_t* keT, long T, float* DECp, const float* wup, const float* bgk, int nvalid, int lane_) {
    int lane = lane_; asm volatile("" : "+v"(lane));
    const int ch = 2 * lane;
    float w0[16], w1[16];
#pragma unroll
    for (int r = 0; r < 16; ++r) { w0[r] = wup[r * 512 + ch]; w1[r] = wup[r * 512 + ch + 1]; }
    const float b0 = bgk[ch], b1 = bgk[ch + 1];
    float s0 = 0.f, s1 = 0.f;
    const float SC = 0.08838834764831845f;
    const int ng = (nvalid + 7) >> 3;
    for (int t8 = ng; t8 < 8; ++t8) { *(u32x4*)(keT + (long)ch * T + t8 * 8) = u32x4{0u, 0u, 0u, 0u}; *(u32x4*)(keT + (long)(ch + 1) * T + t8 * 8) = u32x4{0u, 0u, 0u, 0u}; }
    for (int t8 = 0; t8 < ng; ++t8) {
        unsigned ka[4], kb[4];
#pragma unroll
        for (int tt = 0; tt < 8; ++tt) {
            const int t = t8 * 8 + tt;
            const float* gl = GL + t * 16;
            float z0 = b0, z1 = b1;
#pragma unroll
            for (int r = 0; r < 16; ++r) { const float gv = gl[r]; z0 += gv * w0[r]; z1 += gv * w1[r]; }
            const float g0 = -(fmaxf(-z0, 0.f) + __logf(1.f + __expf(-fabsf(z0)))) * (1.f / 16.f);
            const float g1 = -(fmaxf(-z1, 0.f) + __logf(1.f + __expf(-fabsf(z1)))) * (1.f / 16.f);
            if (t < nvalid) { s0 += g0; s1 += g1; }
            const unsigned q2 = *(const unsigned*)(Qg + (size_t)t * 512 + ch), k2 = *(const unsigned*)(Kg + (size_t)t * 512 + ch);
            const float e0 = __builtin_amdgcn_exp2f(s0 * LOG2E), e1 = __builtin_amdgcn_exp2f(s1 * LOG2E);
            const float i0 = __builtin_amdgcn_exp2f(-s0 * LOG2E), i1 = __builtin_amdgcn_exp2f(-s1 * LOG2E);
            *(unsigned*)(Qg + (size_t)t * 512 + ch) = pk2(bflo(q2) * SC * e0, bfhi(q2) * SC * e1);
            const unsigned kk = pk2(bflo(k2) * i0, bfhi(k2) * i1);
            *(unsigned*)(Kg + (size_t)t * 512 + ch) = kk;
            if (tt & 1) { ka[tt >> 1] |= (kk & 0xffffu) << 16; kb[tt >> 1] |= (kk & 0xffff0000u); }
            else { ka[tt >> 1] = kk & 0xffffu; kb[tt >> 1] = kk >> 16; }
        }
        u32x4 wa, wb; wa.x = ka[0]; wa.y = ka[1]; wa.z = ka[2]; wa.w = ka[3]; wb.x = kb[0]; wb.y = kb[1]; wb.z = kb[2]; wb.w = kb[3];
        *(u32x4*)(keT + (long)ch * T + t8 * 8) = wa; *(u32x4*)(keT + (long)(ch + 1) * T + t8 * 8) = wb;
    }
    DECp[ch] = __builtin_amdgcn_exp2f(s0 * LOG2E); DECp[ch + 1] = __builtin_amdgcn_exp2f(s1 * LOG2E);
}

__device__ __forceinline__ void gate_unit_p(const bf16_t* Qg, const bf16_t* Kg, bf16_t* Qo, bf16_t* Ko, const float* GL, bf16_t* keT, long T, float* DECp, const float* wup, const float* bgk, int nvalid, int lane_) {
    int lane = lane_; asm volatile("" : "+v"(lane));
    const int ch = 2 * lane;
    float w0[16], w1[16];
#pragma unroll
    for (int r = 0; r < 16; ++r) { w0[r] = wup[r * 512 + ch]; w1[r] = wup[r * 512 + ch + 1]; }
    const float b0 = bgk[ch], b1 = bgk[ch + 1];
    float s0 = 0.f, s1 = 0.f;
    const float SC = 0.08838834764831845f;
    for (int t8 = 0; t8 < 8; ++t8) {
        unsigned ka[4], kb[4];
#pragma unroll
        for (int tt = 0; tt < 8; ++tt) {
            const int t = t8 * 8 + tt;
            const float* gl = GL + t * 16;
            float z0 = b0, z1 = b1;
#pragma unroll
            for (int r = 0; r < 16; ++r) { const float gv = gl[r]; z0 += gv * w0[r]; z1 += gv * w1[r]; }
            const float g0 = -(fmaxf(-z0, 0.f) + __logf(1.f + __expf(-fabsf(z0)))) * (1.f / 16.f);
            const float g1 = -(fmaxf(-z1, 0.f) + __logf(1.f + __expf(-fabsf(z1)))) * (1.f / 16.f);
            if (t < nvalid) { s0 += g0; s1 += g1; }
            const unsigned q2 = *(const unsigned*)(Qg + (size_t)t * 512 + ch), k2 = *(const unsigned*)(Kg + (size_t)t * 512 + ch);
            const float e0 = __builtin_amdgcn_exp2f(s0 * LOG2E), e1 = __builtin_amdgcn_exp2f(s1 * LOG2E);
            const float i0 = __builtin_amdgcn_exp2f(-s0 * LOG2E), i1 = __builtin_amdgcn_exp2f(-s1 * LOG2E);
            *(unsigned*)(Qo + (size_t)t * 512 + ch) = pk2(bflo(q2) * SC * e0, bfhi(q2) * SC * e1);
            const unsigned kk = pk2(bflo(k2) * i0, bfhi(k2) * i1);
            *(unsigned*)(Ko + (size_t)t * 512 + ch) = kk;
            if (tt & 1) { ka[tt >> 1] |= (kk & 0xffffu) << 16; kb[tt >> 1] |= (kk & 0xffff0000u); }
            else { ka[tt >> 1] = kk & 0xffffu; kb[tt >> 1] = kk >> 16; }
        }
        u32x4 wa, wb; wa.x = ka[0]; wa.y = ka[1]; wa.z = ka[2]; wa.w = ka[3]; wb.x = kb[0]; wb.y = kb[1]; wb.z = kb[2]; wb.w = kb[3];
        *(u32x4*)(keT + (long)ch * T + t8 * 8) = wa; *(u32x4*)(keT + (long)(ch + 1) * T + t8 * 8) = wb;
    }
    DECp[ch] = __builtin_amdgcn_exp2f(s0 * LOG2E); DECp[ch + 1] = __builtin_amdgcn_exp2f(s1 * LOG2E);
}

template <bool EMIT>
__device__ __forceinline__ void gla_unit(const bf16_t* Qg, const bf16_t* Kg, const bf16_t* keT, const bf16_t* Vt, long T, const bf16_t* Rg, bf16_t* OG, const float* DECp,
                                         const float* gain, const float* Sin, float* Sout, int nsteps, int nvalid, LAS unsigned char* sm, int w, int lane_) {
    int lane = lane_; asm volatile("" : "+v"(lane));
    const int x = lane & 31, hi = lane >> 5; const int sx = (x & 0x13) | ((x & 4) << 1) | ((x & 8) >> 1);
    const int t = w * 64 + lane;
    LAS float* red = (LAS float*)sm;
    constexpr int QC = 4096, KC = QC + 64 * 272, TC = KC + 64 * 272;
    const bf16_t* gq = EMIT ? Qg + (size_t)(t >> 4) * 512 + (t & 15) * 8 : nullptr;
    const bf16_t* gk = EMIT ? Kg + (size_t)(t >> 4) * 512 + (t & 15) * 8 : nullptr;
    const bf16_t* gt = keT + (long)(t >> 3) * T + (t & 7) * 8;
    const int lq = (t >> 4) * 272 + (t & 15) * 16, lt = (t >> 3) * 144 + (t & 7) * 16;
    u32x4 stq[2], stk[2], stt[2];
#define GLA_GLOAD(kk) do { const int tk_ = 64 * (kk); \
        if (EMIT) { stq[0] = *(const u32x4*)(gq + (size_t)tk_ * 512); stq[1] = *(const u32x4*)(gq + (size_t)(tk_ + 32) * 512); \
                    stk[0] = *(const u32x4*)(gk + (size_t)tk_ * 512); stk[1] = *(const u32x4*)(gk + (size_t)(tk_ + 32) * 512); } \
        stt[0] = *(const u32x4*)(gt + tk_); stt[1] = *(const u32x4*)(gt + 64 * T + tk_); } while (0)
    f32x16 S[4];
    if (Sin) {
        const float* sp = Sin + (size_t)(8 * hi) * 256 + x;
#pragma unroll
        for (int dt = 0; dt < 4; ++dt) {
#pragma unroll
            for (int r = 0; r < 16; ++r) S[dt][r] = sp[(32 * dt + 16 * (r >> 3) + (r & 7)) * 256];
            asm volatile("" ::: "memory");
        }
    } else {
#pragma unroll
        for (int dt = 0; dt < 4; ++dt) S[dt] = f32x16{};
    }
    GLA_GLOAD(0);
    for (int k = 0; k < nsteps; ++k) {
        const int tk = 64 * k;
        __syncthreads();
        if (EMIT) { *(LAS u32x4*)(sm + QC + lq) = stq[0]; *(LAS u32x4*)(sm + QC + 32 * 272 + lq) = stq[1]; *(LAS u32x4*)(sm + KC + lq) = stk[0]; *(LAS u32x4*)(sm + KC + 32 * 272 + lq) = stk[1]; }
        *(LAS u32x4*)(sm + TC + lt) = stt[0]; *(LAS u32x4*)(sm + TC + 64 * 144 + lt) = stt[1];
        bf16x8 vf[2][2];
#pragma unroll
        for (int jt = 0; jt < 2; ++jt)
#pragma unroll
            for (int s = 0; s < 2; ++s) vf[jt][s] = *(const bf16x8*)(Vt + (long)x * T + tk + 32 * jt + 16 * s + 8 * hi);
        __syncthreads();
        if (!EMIT) { if (k + 1 < nsteps) GLA_GLOAD(k + 1); }
        f32x16 o0 = f32x16{}, o1 = f32x16{};
        if (EMIT) {
            const LAS unsigned char* q0p = sm + QC + x * 272 + hi * 16; const LAS unsigned char* q1p = q0p + 32 * 272;
            const LAS unsigned char* k0p = sm + KC + sx * 272 + hi * 16; const LAS unsigned char* k1p = k0p + 32 * 272;
            bf16x8 a00_0, a00_1, a01_0, a01_1, a11_0, a11_1;
            {
                f32x16 at00 = f32x16{}, at01 = f32x16{}, at11 = f32x16{};
#pragma unroll
                for (int ds = 0; ds < 8; ++ds) {
                    const bf16x8 q0 = *(const LAS bf16x8*)(q0p + 32 * ds), q1 = *(const LAS bf16x8*)(q1p + 32 * ds);
                    const bf16x8 k0 = *(const LAS bf16x8*)(k0p + 32 * ds), k1 = *(const LAS bf16x8*)(k1p + 32 * ds);
                    at00 = MFMA32(k0, q0, at00); at01 = MFMA32(k0, q1, at01); at11 = MFMA32(k1, q1, at11);
                }
#pragma unroll
                for (int r = 0; r < 16; ++r) { const int j = 16 * (r >> 3) + 8 * hi + (r & 7); if (j > x) { at00[r] = 0.f; at11[r] = 0.f; } }
                a00_0 = pack8(at00, 0); a00_1 = pack8(at00, 8); a01_0 = pack8(at01, 0); a01_1 = pack8(at01, 8); a11_0 = pack8(at11, 0); a11_1 = pack8(at11, 8);
            }
            asm volatile("" : "+v"(a00_0), "+v"(a00_1), "+v"(a01_0), "+v"(a01_1), "+v"(a11_0), "+v"(a11_1));
            if (k + 1 < nsteps) GLA_GLOAD(k + 1);
#pragma unroll
            for (int ds = 0; ds < 8; ++ds) {
                const bf16x8 q0 = *(const LAS bf16x8*)(q0p + 32 * ds), q1 = *(const LAS bf16x8*)(q1p + 32 * ds);
                const bf16x8 sb = pack8(S[ds >> 1], (ds & 1) * 8); o0 = MFMA32(sb, q0, o0); o1 = MFMA32(sb, q1, o1);
            }
            o0 = MFMA32(vf[0][0], a00_0, o0); o0 = MFMA32(vf[0][1], a00_1, o0);
            o1 = MFMA32(vf[0][0], a01_0, o1); o1 = MFMA32(vf[0][1], a01_1, o1);
            o1 = MFMA32(vf[1][0], a11_0, o1); o1 = MFMA32(vf[1][1], a11_1, o1);
        }
#pragma unroll
        for (int dt = 0; dt < 4; ++dt) {
            const LAS unsigned char* tp = sm + TC + (32 * dt + sx) * 144 + hi * 16;
            const float* dp = DECp + (size_t)k * 512 + 32 * dt + 8 * hi;
            float dc[16];
#pragma unroll
            for (int r = 0; r < 16; ++r) dc[r] = dp[16 * (r >> 3) + (r & 7)];
            f32x16 acc = S[dt];
#pragma unroll
            for (int jt = 0; jt < 2; ++jt)
#pragma unroll
                for (int s = 0; s < 2; ++s) { const bf16x8 kf = *(const LAS bf16x8*)(tp + 64 * jt + 32 * s); acc = MFMA32(kf, vf[jt][s], acc); }
#pragma unroll
            for (int r = 0; r < 16; ++r) S[dt][r] = acc[r] * dc[r];
        }
        if (EMIT) {
            float ss0 = 0.f, ss1 = 0.f;
#pragma unroll
            for (int r = 0; r < 16; ++r) { ss0 += o0[r] * o0[r]; ss1 += o1[r] * o1[r]; }
            ss0 = xhalf_sum(ss0); ss1 = xhalf_sum(ss1);
            LAS float* rp = red + (k & 1) * 512;
            if (hi == 0) { rp[w * 64 + x] = ss0; rp[w * 64 + 32 + x] = ss1; }
            __syncthreads();
            float t0 = 0.f, t1 = 0.f;
#pragma unroll
            for (int ww = 0; ww < 8; ++ww) { t0 += rp[ww * 64 + x]; t1 += rp[ww * 64 + 32 + x]; }
            const float r0 = 1.f / sqrtf(t0 * (1.f / 256.f) + GN_EPS), r1 = 1.f / sqrtf(t1 * (1.f / 256.f) + GN_EPS);
#pragma unroll
            for (int it = 0; it < 2; ++it) {
                const int i = 32 * it + x; const float rs = it ? r1 : r0;
                if (i < nvalid) {
#pragma unroll
                    for (int r4 = 0; r4 < 4; ++r4) {
                        const int vc = 8 * r4 + 4 * hi;
                        const f32x4 gg = *(const f32x4*)(gain + vc);
                        const u32x2 rr = *(const u32x2*)(Rg + (size_t)(tk + i) * 1024 + vc);
                        const f32x16& oo = it ? o1 : o0;
                        u32x2 wv; wv.x = pk2(oo[4 * r4 + 0] * rs * gg[0] * silu_f(bflo(rr.x)), oo[4 * r4 + 1] * rs * gg[1] * silu_f(bfhi(rr.x)));
                        wv.y = pk2(oo[4 * r4 + 2] * rs * gg[2] * silu_f(bflo(rr.y)), oo[4 * r4 + 3] * rs * gg[3] * silu_f(bfhi(rr.y)));
                        *(u32x2*)(OG + (size_t)(tk + i) * 1024 + vc) = wv;
                    }
                }
            }
        }
    }
#undef GLA_GLOAD
    if (Sout) {
        float* sp = Sout + (size_t)(8 * hi) * 256 + x;
#pragma unroll
        for (int dt = 0; dt < 4; ++dt) {
#pragma unroll
            for (int r = 0; r < 16; ++r) sp[(32 * dt + 16 * (r >> 3) + (r & 7)) * 256] = S[dt][r];
            asm volatile("" ::: "memory");
        }
    }
}

#define XB_TMO      128
#define XB_XCNT(j)  (256  + 64 * (j))
#define XB_XSUB(j)  (1280 + 64 * (j))
#define XB_XGEN(j)  (2304 + 64 * (j))
#define XB_TOP      3328
#define XB_TOPGEN   3392
#define XCD_BAR_WORDS 3456
#define XB_SPIN_CAP (1u << 18)

__device__ __forceinline__ unsigned xb_ld(unsigned* p)              { return __hip_atomic_load(p, __ATOMIC_RELAXED, __HIP_MEMORY_SCOPE_AGENT); }
__device__ __forceinline__ unsigned xb_add(unsigned* p, unsigned v) { return __hip_atomic_fetch_add(p, v, __ATOMIC_RELAXED, __HIP_MEMORY_SCOPE_AGENT); }
__device__ __forceinline__ unsigned xb_xcc_id() { return (unsigned)__builtin_amdgcn_s_getreg((3 << 11) | 20) & 0xFu; }
#define XB_SPIN(cond, bar) do { unsigned _sp = 0; while (cond) { __builtin_amdgcn_s_sleep(1); \
    if ((++_sp & 255u) == 0u) { if (xb_ld(&(bar)[XB_TMO])) break; if (_sp > XB_SPIN_CAP) { atomicAdd(&(bar)[XB_TMO], 1u); break; } } } } while (0)

struct XcdBarrier {
    unsigned* bar; unsigned x;
    volatile LAS unsigned* st;
};

__device__ __forceinline__ XcdBarrier xcd_barrier_post(unsigned* bar, volatile LAS unsigned* st) {
    XcdBarrier b; b.bar = bar; b.x = xb_xcc_id(); b.st = st;
    if (threadIdx.x == 0) (void)xb_add(&bar[XB_XCNT(b.x)], 1u);
    return b;
}
__device__ __forceinline__ void xcd_barrier_complete(unsigned* bar, unsigned x, unsigned& nloc, unsigned& nx) {
    const unsigned G = gridDim.x * gridDim.y * gridDim.z;
    unsigned sum, cnt, mine, sp = 0u;
    for (;;) {
        sum = 0u; cnt = 0u; mine = 0u;
#pragma unroll
        for (unsigned j = 0; j < 16; ++j) { const unsigned c = xb_ld(&bar[XB_XCNT(j)]); sum += c; cnt += (c > 0u) ? 1u : 0u; }
        mine = xb_ld(&bar[XB_XCNT(x)]);
        if (sum == G) break;
        __builtin_amdgcn_s_sleep(1);
        if ((++sp & 255u) == 0u) { if (xb_ld(&bar[XB_TMO])) break; if (sp > XB_SPIN_CAP) { atomicAdd(&bar[XB_TMO], 1u); break; } }
    }
    nloc = mine > 0u ? mine : 1u; nx = cnt > 0u ? cnt : 1u;
}

__device__ __forceinline__ void xcd_barrier(const XcdBarrier& b) {
    asm volatile("s_waitcnt vmcnt(0)" ::: "memory");
    __syncthreads();
    if (threadIdx.x == 0) {
        unsigned* bar = b.bar;
        __builtin_amdgcn_s_waitcnt(0);
        unsigned nloc = b.st[0], nx = b.st[1];
        if (nloc == 0u) { xcd_barrier_complete(bar, b.x, nloc, nx); b.st[0] = nloc; b.st[1] = nx; }
        const unsigned old = xb_add(&bar[XB_XSUB(b.x)], 1u);
        const unsigned gen = old / nloc;
        if (old + 1u == (gen + 1u) * nloc) {
            __builtin_amdgcn_fence(__ATOMIC_RELEASE, "agent");
            asm volatile("s_waitcnt vmcnt(0)" ::: "memory");
            const unsigned og = xb_add(&bar[XB_TOP], 1u);
            const unsigned tg = og / nx;
            if (og + 1u == (tg + 1u) * nx) xb_add(&bar[XB_TOPGEN], 1u);
            else XB_SPIN(xb_ld(&bar[XB_TOPGEN]) == tg, bar);
            __builtin_amdgcn_fence(__ATOMIC_ACQUIRE, "agent");
            xb_add(&bar[XB_XGEN(b.x)], 1u);
            asm volatile("s_waitcnt vmcnt(0)" ::: "memory");
        } else {
            XB_SPIN(xb_ld(&bar[XB_XGEN(b.x)]) == gen, bar);
            __builtin_amdgcn_fence(__ATOMIC_ACQUIRE, "agent");
            asm volatile("s_waitcnt vmcnt(0)" ::: "memory");
        }
    }
    __syncthreads();
}

struct Args { const float* in[19]; float* out; unsigned char* ws; int lo, hi; };

template <class Epi, bool ATILED = false>
__device__ __forceinline__ void run_gemm(LAS unsigned char* lds, const bf16_t* A, const bf16_t* Bt, int M, int N, int K, const Epi& E, int G, int bid) {
    pg8::Gemm g{A, Bt, M, N, K}; pg8::StaticOrder S; S.init(M, N, G, bid);
    pg8::gemm_phase<Epi, pg8::StaticOrder, true, true, ATILED>(lds, g, S, E);
}

enum { IN_XP = 0, IN_XS, IN_CK, IN_CV, IN_SB, IN_WINA, IN_REL, IN_WOUTA, IN_WINB, IN_WGK, IN_BGK, IN_GN, IN_WOUTB, IN_WFI, IN_WFO, IN_L1G, IN_L1B, IN_L2G, IN_L2B };
constexpr int NPHASE = 18;
#ifndef MK_PHMASK
#define MK_PHMASK 0xFFFFFFFFu
#endif
#ifndef MK_REP_GEMM
#define MK_REP_GEMM 1
#endif
#ifndef MK_REP_SMALL
#define MK_REP_SMALL 1
#endif
#ifndef MK_REP_ATT
#define MK_REP_ATT 1
#endif
#ifndef MK_REP_GLA
#define MK_REP_GLA 1
#endif
#ifndef MK_REP_LN
#define MK_REP_LN 1
#endif
#define PH_OFF(k) ((((unsigned)MK_PHMASK) >> (k)) & 1u) == 0u

#define WINA ((bf16_t*)(ws + WS_WINA))
#define WOUTA ((bf16_t*)(ws + WS_WOUTA))
#define WINB ((bf16_t*)(ws + WS_WINB))
#define WOUTB ((bf16_t*)(ws + WS_WOUTB))
#define WFI ((bf16_t*)(ws + WS_WFI))
#define WFO ((bf16_t*)(ws + WS_WFO))
#define X ((bf16_t*)(ws + WS_X))
#define XS ((bf16_t*)(ws + WS_XS))
#define Q ((bf16_t*)(ws + WS_Q))
#define KB ((bf16_t*)(ws + WS_KB))
#define VT ((bf16_t*)(ws + WS_VT))
#define H ((bf16_t*)(ws + WS_H))
#define AO ((bf16_t*)(ws + WS_AO))
#define AOS ((bf16_t*)(ws + WS_AOS))
#define QS ((bf16_t*)(ws + WS_QS))
#define KSA ((bf16_t*)(ws + WS_KSA))
#define VTSA ((bf16_t*)(ws + WS_VTSA))
#define HS ((bf16_t*)(ws + WS_HS))
#define QG ((bf16_t*)(ws + WS_QG))
#define KG ((bf16_t*)(ws + WS_KG))
#define VT1 ((bf16_t*)(ws + WS_VT1))
#define RG ((bf16_t*)(ws + WS_RG))
#define GL ((float*)(ws + WS_GL))
#define KET ((bf16_t*)(ws + WS_KET))
#define OG ((bf16_t*)(ws + WS_OG))
#define TG ((float*)(ws + WS_TG))
#define DEC ((float*)(ws + WS_DEC))
#define PDG ((float*)(ws + WS_PDG))
#define QGS ((bf16_t*)(ws + WS_QGS))
#define KGS ((bf16_t*)(ws + WS_KGS))
#define VTS ((bf16_t*)(ws + WS_VTS))
#define RGS ((bf16_t*)(ws + WS_RGS))
#define GLS ((float*)(ws + WS_GLS))
#define KETS ((bf16_t*)(ws + WS_KETS))
#define DECS ((float*)(ws + WS_DECS))
#define OGS ((bf16_t*)(ws + WS_OGS))
#define PREA ((bf16_t*)(ws + ACT + 64 * MiB))
#define PREB ((bf16_t*)(ws + ACT + 192 * MiB))
#define PRES (out + O_YS)
#ifndef MK_VAR
#define MK_VAR 0
#endif
template <int PH, int VAR = 0>
__device__ __forceinline__ void do_phase(const Args& a, LAS unsigned char* lds, int wave0) {
    constexpr int ph = PH;
    typedef __attribute__((address_space(1))) unsigned char gu8_t; typedef __attribute__((address_space(1))) float gf32_t;
    unsigned long long wsi_ = (unsigned long long)a.ws, oui_ = (unsigned long long)a.out; asm volatile("" : "+s"(wsi_), "+s"(oui_));
    gu8_t* ws = (gu8_t*)wsi_; gf32_t* out_g = (gf32_t*)oui_;
#define out ((float*)out_g)
    int wave = wave0, bid = blockIdx.x, G = gridDim.x; asm volatile("" : "+s"(wave), "+s"(bid), "+s"(G));
    const int gw = bid * 8 + wave, ngw = G * 8; const size_t gthreads = (size_t)G * 512; (void)gw; (void)ngw; (void)gthreads;
#define PHASE_IDS() int tid = threadIdx.x; asm volatile("" : "+v"(tid)); const int lane = tid & 63; const size_t gtid = (size_t)bid * 512 + tid; (void)lane; (void)gtid;
        switch (ph) {
        case 0: { if constexpr (PH_OFF(0)) break; PHASE_IDS();
            LAS float* scr = (LAS float*)(lds + wave * 8704);
            constexpr int I0 = 16 * 96, I1 = 16 * 32, I2 = 16 * 97, I3 = 16 * 32, I4 = 16 * 176, I5 = 44 * 32;
            constexpr int NIT = I0 + I1 + I2 + I3 + 2 * I4 + 2 * I5;
            for (int it = gw; it < NIT; it += ngw) {
                int r = it;
                if (r < I0) { tr_item(a.in[IN_WINA], 1024, 3072, WINA, 0, scr, r, lane); continue; } r -= I0;
                if (r < I1) { tr_item(a.in[IN_WOUTA], 1024, 1024, WOUTA, 0, scr, r, lane); continue; } r -= I1;
                if (r < I2) { tr_item(a.in[IN_WINB], 1024, 3088, WINB, 0, scr, r, lane); continue; } r -= I2;
                if (r < I3) { tr_item(a.in[IN_WOUTB], 1024, 1024, WOUTB, 0, scr, r, lane); continue; } r -= I3;
                if (r < 2 * I4) { const int l = r / I4; tr_item(a.in[IN_WFI] + (size_t)l * 1024 * 5632, 1024, 5632, WFI + (size_t)l * 5632 * 1024, 1, scr, r - l * I4, lane); continue; } r -= 2 * I4;
                { const int l = r / I5; tr_item(a.in[IN_WFO] + (size_t)l * DFF * 1024, DFF, 1024, WFO + (size_t)l * 1024 * DFF, 0, scr, r - l * I5, lane); }
            }
            for (size_t e = gtid; e < (size_t)(NGLA - 3104) * 1024 / 8; e += gthreads) ((u32x4*)(WINB + (size_t)3104 * 1024))[e] = u32x4{0u, 0u, 0u, 0u};
            { const f32x4* src = (const f32x4*)a.in[IN_XP]; u32x2* dst = (u32x2*)X;
              for (size_t e = gtid; e < (size_t)MP * 1024 / 8; e += 4 * gthreads) { f32x4 v[4][2];
#pragma unroll
                  for (int q = 0; q < 4; ++q) { v[q][0] = src[2 * (e + q * gthreads)]; v[q][1] = src[2 * (e + q * gthreads) + 1]; }
#pragma unroll
                  for (int q = 0; q < 4; ++q) { u32x4 w; w.x = pk2(v[q][0][0], v[q][0][1]); w.y = pk2(v[q][0][2], v[q][0][3]); w.z = pk2(v[q][1][0], v[q][1][1]); w.w = pk2(v[q][1][2], v[q][1][3]);
                      ((u32x4*)dst)[e + q * gthreads] = w; } } }
            { const f32x4* src = (const f32x4*)a.in[IN_XS]; u32x2* dst = (u32x2*)XS;
              for (size_t e = gtid; e < (size_t)MS * 1024 / 4; e += gthreads) { const f32x4 v = src[e]; u32x2 w; w.x = pk2(v[0], v[1]); w.y = pk2(v[2], v[3]); dst[e] = w; } }
            { const f32x4* srck = (const f32x4*)a.in[IN_CK]; const f32x4* srcv = (const f32x4*)a.in[IN_CV];
              for (size_t e = gtid; e < (size_t)8 * 512 * 256; e += gthreads) { const int c = (int)(e & 255) * 4, j = (int)((e >> 8) & 511), bs = (int)(e >> 17);
                  const f32x4 kv = srck[e], vv = srcv[e];
                  u32x2 w; w.x = pk2(kv[0], kv[1]); w.y = pk2(kv[2], kv[3]); *(u32x2*)(KSA + kf_addr(bs * 16 + (c >> 6), 18, j, c & 63)) = w;
                  bf16_t* d2 = VTSA + vf_addr(bs * 16 + (c >> 6), 18, j, c & 63);
#pragma unroll
                  for (int q = 0; q < 4; ++q) d2[q * 8] = f2bf(vv[q]); }
              for (size_t e = gtid; e < (size_t)128 * 512; e += gthreads) { const int bh = (int)(e >> 9), o = (int)(e & 511) * 8;
                  *(u32x4*)(KSA + ((size_t)bh * 18 + 16) * 2048 + o) = u32x4{0u, 0u, 0u, 0u}; *(u32x4*)(VTSA + ((size_t)bh * 18 + 16) * 2048 + o) = u32x4{0u, 0u, 0u, 0u}; } }
            for (size_t e = gtid; e < (2 * MiB) / 16; e += gthreads) ((u32x4*)(ws + WS_QGS))[e] = u32x4{0u, 0u, 0u, 0u};
            for (size_t e = gtid; e < (32 * 1024) / 16; e += gthreads) ((u32x4*)(ws + WS_GLS))[e] = u32x4{0u, 0u, 0u, 0u};
        } break;
        case 1: { if constexpr (PH_OFF(1)) break; PHASE_IDS();
            EpiQKV E{Q, KB, VT, out + O_AKP, out + O_AVP};
            run_gemm(lds, X, WINA, MP, 2048, 1024, E, G, bid);
            { EpiVT<0> EV{VT, out + O_AVP}; run_gemm(lds, WINA + (size_t)2048 * 1024, X, 1024, MP, 1024, EV, G, bid); }
            SQkv SE{QS, KSA, VTSA, out + O_AKS, out + O_AVS};
            for (int rep_ = 0; rep_ < MK_REP_SMALL; ++rep_) { small_gemm<false>(XS, WINA, 1024, 96, (LAS float*)lds, wave, lane, SE); }
        } break;
        case 2: { if constexpr (PH_OFF(2)) break; PHASE_IDS();
            LAS float* lb = (LAS float*)lds;
            const float* rel = a.in[IN_REL];
            for (int e = tid; e < 320 * 16; e += 512) { const int idx = e >> 4, h = e & 15; const int ic = idx > 256 ? 256 : idx; lb[h * 324 + idx] = (rel[ic * 16 + h] - rel[256 * 16 + h]) * LOG2E; }
            __syncthreads();
            const bool xmap = (G == 256);
            const int nui = xmap ? 8 : (8192 + 128 + ngw - 1) / ngw;
            unsigned failmask = 0u;
#define ATT_UNIT_INDEX(ui, u) do { if (xmap) { const int lw = (bid >> 3) * 8 + wave, stream = (bid & 7) * 4 + (ui); \
        if ((ui) < 4) u = ((stream >> 4) << 12) | (lw << 4) | (stream & 15); \
        else { const int j_ = (ui) - 4, cnt_ = (0x00122344 >> (4 * wave)) & 15, st_ = wave == 0 ? 0 : wave == 1 ? 4 : wave == 2 ? 8 : wave == 3 ? 11 : wave == 4 ? 13 : wave == 5 ? 15 : 16; \
               u = (bid < 8 && j_ < cnt_) ? 8192 + bid * 16 + st_ + j_ : 1 << 30; } \
      } else u = gw + (ui) * ngw; } while (0)
            for (int ui = 0; ui < nui; ++ui) {
                int u; ATT_UNIT_INDEX(ui, u);
                if (u >= 8192 + 128) continue;
                bool ok;
                if (u < 8192) {
                    const int h = u & 15, c = (u >> 4) & 255, b = u >> 12; const long row0 = (long)b * 16384 + c * 64;
                    const long tile0 = (long)(b * 16 + h) * 512 + (2 * c - 16);
                    const int kt_lo = (16 - 2 * c) > 0 ? (16 - 2 * c) : 0;
                    ok = attn_unit_fast<2>(Q + row0 * 1024 + h * 64, 64, KB + tile0 * 2048, VT + tile0 * 2048, kt_lo, 18, 576, lb + h * 324, rel[256 * 16 + h] * LOG2E, AO + row0 * 1024 + h * 64, lane);
                } else {
                    const int su = u - 8192, h = su & 15, bs = su >> 4;
                    ok = attn_unit_fast<1>(QS + (size_t)bs * 16 * 1024 + h * 64, 16, KSA + (size_t)(bs * 16 + h) * 18 * 2048, VTSA + (size_t)(bs * 16 + h) * 18 * 2048, 0, 17, 528, lb + h * 324, rel[256 * 16 + h] * LOG2E,
                                           AOS + (size_t)bs * 16 * 1024 + h * 64, lane);
                }
                if (!ok) failmask |= 1u << (ui & 31);
            }
            asm volatile("" ::: "memory");
            if (failmask) {
                for (int ui = 0; ui < nui; ++ui) {
                    if (!((failmask >> (ui & 31)) & 1u)) continue;
                    int u; ATT_UNIT_INDEX(ui, u);
                    if (u >= 8192 + 128) continue;
                    if (u < 8192) {
                        const int h = u & 15, c = (u >> 4) & 255, b = u >> 12; const long row0 = (long)b * 16384 + c * 64;
                        const long tile0 = (long)(b * 16 + h) * 512 + (2 * c - 16);
                        const int kt_lo = (16 - 2 * c) > 0 ? (16 - 2 * c) : 0;
                        attn_unit_safe<2>(Q + row0 * 1024 + h * 64, 64, KB + tile0 * 2048, VT + tile0 * 2048, kt_lo, 18, 576, lb + h * 324, rel[256 * 16 + h] * LOG2E, AO + row0 * 1024 + h * 64, lane);
                    } else {
                        const int su = u - 8192, h = su & 15, bs = su >> 4;
                        attn_unit_safe<1>(QS + (size_t)bs * 16 * 1024 + h * 64, 16, KSA + (size_t)(bs * 16 + h) * 18 * 2048, VTSA + (size_t)(bs * 16 + h) * 18 * 2048, 0, 17, 528, lb + h * 324, rel[256 * 16 + h] * LOG2E,
                                          AOS + (size_t)bs * 16 * 1024 + h * 64, lane);
                    }
                }
            }
#undef ATT_UNIT_INDEX
            __syncthreads();
        } break;
        case 3: case 13: { if constexpr (PH_OFF(3)) break; PHASE_IDS();
            const bool l1 = (ph == 13);
            EpiRes E{X, PREA};
            for (int rep_ = 0; rep_ < MK_REP_GEMM; ++rep_) { run_gemm(lds, l1 ? OG : AO, l1 ? WOUTB : WOUTA, MP, 1024, 1024, E, G, bid); }
            SRes SE{XS, PRES};
            for (int rep_ = 0; rep_ < MK_REP_SMALL; ++rep_) { small_gemm<false>(l1 ? OGS : AOS, l1 ? WOUTB : WOUTA, 1024, 32, (LAS float*)lds, wave, lane, SE); }
        } break;
        case 4: case 7: case 14: case 17: { if constexpr (PH_OFF(4)) break; PHASE_IDS();
            const int layer = ph >= 14 ? 1 : 0; const bool second = (ph == 7 || ph == 17);
            const float* g = a.in[second ? IN_L2G : IN_L1G] + layer * 1024; const float* bt = a.in[second ? IN_L2B : IN_L1B] + layer * 1024;
            const bool fin = (ph == 17);
            if constexpr (ph == 4 || ph == 14) lnb_rows<4, true>(PREA, MP, g, bt, X, nullptr, gw, ngw, lane);
            else lnb_rows<4>(second ? PREB : PREA, MP, g, bt, fin ? nullptr : X, fin ? out + O_YP : nullptr, gw, ngw, lane);
            ln_rows(PRES, MS, g, bt, fin ? nullptr : XS, fin ? PRES : nullptr, gw, ngw, lane);
        } break;
        case 5: case 15: { if constexpr (PH_OFF(5)) break; PHASE_IDS();
            const int layer = ph == 15 ? 1 : 0; const bf16_t* W = WFI + (size_t)layer * 5632 * 1024;
            EpiSwi E{H};
            for (int rep_ = 0; rep_ < MK_REP_GEMM; ++rep_) { run_gemm<EpiSwi, true>(lds, X, W, MP, 5632, 1024, E, G, bid); }
            SSwi SE{HS};
            for (int rep_ = 0; rep_ < MK_REP_SMALL; ++rep_) { small_gemm<true>(XS, W, 1024, 88, (LAS float*)lds, wave, lane, SE); }
        } break;
        case 6: case 16: { if constexpr (PH_OFF(6)) break; PHASE_IDS();
            const int layer = ph == 16 ? 1 : 0; const bf16_t* W = WFO + (size_t)layer * 1024 * DFF;
            EpiResT<true> E{X, PREB};
            for (int rep_ = 0; rep_ < MK_REP_GEMM; ++rep_) { run_gemm<EpiResT<true>, true>(lds, H, W, MP, 1024, DFF, E, G, bid); }
            SRes SE{XS, PRES};
            for (int rep_ = 0; rep_ < MK_REP_SMALL; ++rep_) { small_gemm<false>(HS, W, DFF, 32, (LAS float*)lds, wave, lane, SE); }
        } break;
        case 8: { if constexpr (PH_OFF(8)) break; PHASE_IDS();
            EpiGla E{QG, KG, VT1, RG, GL};
            run_gemm(lds, X, WINB, MP, 1024, 1024, E, G, bid);
            { EpiGlaR ER{RG, GL}; run_gemm(lds, X, WINB + (size_t)2048 * 1024, MP, 1280, 1024, ER, G, bid); }
            { EpiVT<1> EV{VT1, nullptr}; run_gemm(lds, WINB + (size_t)1024 * 1024, X, 1024, MP, 1024, EV, G, bid); }
            SGla SE{QGS, KGS, VTS, RGS, GLS};
            for (int rep_ = 0; rep_ < MK_REP_SMALL; ++rep_) { small_gemm<false>(XS, WINB, 1024, 97, (LAS float*)lds, wave, lane, SE); }
        } break;
        case 9: { if constexpr (PH_OFF(9)) break; PHASE_IDS();
            const float* wup = a.in[IN_WGK]; const float* bgk = a.in[IN_BGK];
            for (int u = gw; u < 2048 + 32; u += ngw) {
                if (u < 2048) { const int h = u & 3, ck = u >> 2, b = ck >> 8; const size_t row0 = (size_t)ck * 64;
                    if (VAR) gate_unit_p(QG + row0 * 512 + h * 128, KG + row0 * 512 + h * 128, OG + row0 * 512 + h * 128, OG + (size_t)MP * 512 + row0 * 512 + h * 128, GL + row0 * 16, (bf16_t*)TG + (size_t)(b * 512 + h * 128) * 16384 + (ck & 255) * 64, 16384,
                              DEC + (size_t)ck * 512 + h * 128, wup + h * 128, bgk + h * 128, 64, lane);
                    else
                    gate_unit(QG + row0 * 512 + h * 128, KG + row0 * 512 + h * 128, GL + row0 * 16, KET + (size_t)(b * 512 + h * 128) * 16384 + (ck & 255) * 64, 16384,
                              DEC + (size_t)ck * 512 + h * 128, wup + h * 128, bgk + h * 128, 64, lane);
                } else if (!VAR) { const int su = u - 2048, h = su & 3, bs = su >> 2;
                    gate_unit(QGS + (size_t)bs * 64 * 512 + h * 128, KGS + (size_t)bs * 64 * 512 + h * 128, GLS + bs * 64 * 16, KETS + (size_t)(bs * 512 + h * 128) * 64, 64,
                              DECS + bs * 512 + h * 128, wup + h * 128, bgk + h * 128, 16, lane); }
            }
        } break;
        case 10: { if constexpr (PH_OFF(10)) break; PHASE_IDS();
            LAS unsigned char* red = lds;
            for (int rep_ = 0; rep_ < MK_REP_GLA; ++rep_)
            for (int u = bid; u < 256; u += G) {
                const int g = u & 31, bh = u >> 5, h = bh & 3, b = bh >> 2; const int ck0 = b * 256 + 8 * g;
                gla_unit<false>(nullptr, nullptr, KET + (size_t)(b * 512 + h * 128) * 16384 + 512 * g, VT1 + (size_t)(b * 1024 + h * 256 + 32 * wave) * 16384 + 512 * g, 16384, nullptr, nullptr,
                                DEC + (size_t)ck0 * 512 + h * 128, nullptr, nullptr, TG + (size_t)u * 32768 + 32 * wave, 8, 64, red, wave, lane);
                if (wave == 0) {
#pragma unroll
                    for (int q = 0; q < 2; ++q) { const int d = lane + 64 * q; float pd = 1.f;
#pragma unroll
                        for (int c = 0; c < 8; ++c) pd *= DEC[(size_t)(ck0 + c) * 512 + h * 128 + d];
                        PDG[u * 128 + d] = pd; }
                }
            }
        } break;
        case 12: { if constexpr (PH_OFF(12)) break; PHASE_IDS();
            LAS unsigned char* red = lds;
            const float* gain = a.in[IN_GN];
            for (int rep_ = 0; rep_ < MK_REP_GLA; ++rep_)
            for (int u = bid; u < 256; u += G) {
                const int g = u & 31, bh = u >> 5, h = bh & 3, b = bh >> 2; const int ck0 = b * 256 + 8 * g; const size_t row0 = (size_t)ck0 * 64;
                gla_unit<true>(QG + row0 * 512 + h * 128, KG + row0 * 512 + h * 128, KET + (size_t)(b * 512 + h * 128) * 16384 + 512 * g, VT1 + (size_t)(b * 1024 + h * 256 + 32 * wave) * 16384 + 512 * g, 16384,
                               RG + row0 * 1024 + h * 256 + 32 * wave, OG + row0 * 1024 + h * 256 + 32 * wave, DEC + (size_t)ck0 * 512 + h * 128, gain + h * 256 + 32 * wave,
                               TG + (size_t)u * 32768 + 32 * wave, g == 31 ? out + O_SBP + (size_t)bh * 32768 + 32 * wave : nullptr, 8, 64, red, wave, lane);
                __syncthreads();
            }
            asm volatile("" ::: "memory");
            for (int su = bid; su < 32; su += G) {
                const int h = su & 3, bs = su >> 2;
                gla_unit<true>(QGS + (size_t)bs * 64 * 512 + h * 128, KGS + (size_t)bs * 64 * 512 + h * 128, KETS + (size_t)(bs * 512 + h * 128) * 64, VTS + (size_t)(bs * 1024 + h * 256 + 32 * wave) * 64, 64,
                               RGS + (size_t)bs * 16 * 1024 + h * 256 + 32 * wave, OGS + (size_t)bs * 16 * 1024 + h * 256 + 32 * wave, DECS + bs * 512 + h * 128, gain + h * 256 + 32 * wave,
                               a.in[IN_SB] + (size_t)su * 32768 + 32 * wave, out + O_SBS + (size_t)su * 32768 + 32 * wave, 1, 16, red, wave, lane);
                __syncthreads();
            }
        } break;
        case 11: { if constexpr (PH_OFF(11)) break; PHASE_IDS();
            for (size_t e = gtid; e < 262144; e += gthreads) {
                const int bh = (int)(e >> 15), dv = (int)(e & 32767), d = dv >> 8;
                float t[32], pd[32];
#pragma unroll
                for (int g = 0; g < 32; ++g) { t[g] = TG[((size_t)bh * 32 + g) * 32768 + dv]; pd[g] = PDG[(bh * 32 + g) * 128 + d]; }
                float S = 0.f;
#pragma unroll
                for (int g = 0; g < 32; ++g) { (VAR ? (float*)OG : TG)[((size_t)bh * 32 + g) * 32768 + dv] = S; S = pd[g] * S + t[g]; }
            }
        } break;
        default: break;
        }
#undef out
}

#ifndef MK_DUP
#define MK_DUP (-1)
#endif
__global__ void __launch_bounds__(512, 2) mk_fwd(Args a) {
    extern __shared__ __attribute__((aligned(16))) unsigned char lds_raw[];
    LAS unsigned char* lds = (LAS unsigned char*)lds_raw;
    const int wave0 = __builtin_amdgcn_readfirstlane((int)threadIdx.x >> 6);
    cg::grid_group grid = cg::this_grid();
    volatile LAS unsigned* bst = (volatile LAS unsigned*)(lds + 131072);
    if (threadIdx.x < 64) bst[threadIdx.x] = 0u;
    __syncthreads();
    XcdBarrier xbar = xcd_barrier_post((unsigned*)a.ws, bst);
    if (a.lo < 0) grid.sync();
#define SEAM(k) do { if ((k) + 1 < a.hi) xcd_barrier(xbar); } while (0)
#define PHASE(k) do { if (a.lo <= (k) && (k) < a.hi) { do_phase<k>(a, lds, wave0); if (MK_DUP == (k)) { xcd_barrier(xbar); do_phase<k, MK_VAR>(a, lds, wave0); } SEAM(k); } } while (0)
    PHASE(0); PHASE(1); PHASE(2); PHASE(3); PHASE(4); PHASE(5); PHASE(6); PHASE(7); PHASE(8); PHASE(9);
    PHASE(10); PHASE(11); PHASE(12); PHASE(13); PHASE(14); PHASE(15); PHASE(16); PHASE(17);
#undef PHASE
#undef SEAM
}
#undef WINA
#undef WOUTA
#undef WINB
#undef WOUTB
#undef WFI
#undef WFO
#undef X
#undef XS
#undef Q
#undef KB
#undef VT
#undef H
#undef AO
#undef AOS
#undef QS
#undef KSA
#undef VTSA
#undef HS
#undef QG
#undef KG
#undef VT1
#undef RG
#undef GL
#undef KET
#undef OG
#undef TG
#undef DEC
#undef PDG
#undef QGS
#undef KGS
#undef VTS
#undef RGS
#undef GLS
#undef KETS
#undef DECS
#undef OGS
#undef PREA
#undef PREB
#undef PRES
extern "C" void kernel_launch(void* const* d_in, const int* in_sizes, int n_in, void* d_out, int out_size, void* d_ws, size_t ws_size, hipStream_t stream) {
    static int grid = 0;
    if (grid == 0) {
        int dev = 0, cus = 0, per_cu = 0;
        (void)hipGetDevice(&dev); (void)hipDeviceGetAttribute(&cus, hipDeviceAttributeMultiprocessorCount, dev);
        (void)hipFuncSetAttribute((const void*)mk_fwd, hipFuncAttributeMaxDynamicSharedMemorySize, LDS_BYTES);
        (void)hipOccupancyMaxActiveBlocksPerMultiprocessor(&per_cu, (const void*)mk_fwd, 512, LDS_BYTES);
        if (per_cu < 1) per_cu = 1;
        grid = cus * 1;
        if (grid <= 0) grid = 256;
    }
    Args a{};
    for (int i = 0; i < 19; ++i) a.in[i] = (const float*)d_in[i];
    a.out = (float*)d_out; a.ws = (unsigned char*)d_ws;
    (void)hipMemsetAsync(d_ws, 0, 65536, stream);
#if MK_MULTI
    for (int ph = 0; ph < NPHASE; ++ph) { a.lo = ph; a.hi = ph + 1; hipLaunchKernelGGL(mk_fwd, dim3(grid), dim3(512), LDS_BYTES, stream, a); }
#else
    a.lo = 0; a.hi = NPHASE;
    void* args[] = {&a};
    (void)hipLaunchCooperativeKernel((const void*)mk_fwd, dim3(grid), dim3(512), args, LDS_BYTES, stream);
#endif
}
```
